# Optimizing an MI355X kernel written in HIP

```python
import math
import jax, jax.numpy as jnp
from jax import lax
import numpy as np

D_MODEL = 1024
BATCH = 8
SEQ = 2048
DEPTH = 1

CONV_DIM = D_MODEL // 2
CONV_WIDTH = 3
N_HEADS = 8
HEAD_DIM = 64
N_KV_GROUPS = 2
HEADS_PER_GROUP = N_HEADS // N_KV_GROUPS
NSA_DIM = N_HEADS * HEAD_DIM
KV_DIM = N_KV_GROUPS * HEAD_DIM
ROPE_DIM = HEAD_DIM // 4
ROPE_THETA = 500000.0
CMP_BLOCK = 32
CMP_STRIDE = 16
CMP_HIDDEN = 2 * HEAD_DIM
SEL_BLOCK = 64
N_SEL = 16
WINDOW = 512
Q_BLOCK = 128
SEL_Q_CHUNK = 64
N_NSA_BRANCHES = 3
D_FF = 4 * D_MODEL
ALPHA = (2 * DEPTH) ** 0.25
BETA = (8 * DEPTH) ** -0.25
LN_EPS = 1e-5
NEG = -1e30
FORCE = 1e9

IN_SPLITS = (CONV_DIM, CONV_DIM, CONV_DIM, NSA_DIM,
             KV_DIM, KV_DIM, KV_DIM, KV_DIM, KV_DIM, KV_DIM,
             N_HEADS * N_NSA_BRANCHES, D_MODEL, D_MODEL)
N_IN = sum(IN_SPLITS)

kernel_name = "hybrid_conv_nsa_deepnorm_block"


def layer_norm(x, g, b):
    xf = x.astype(jnp.float32)
    mu = xf.mean(-1, keepdims=True)
    var = jnp.square(xf - mu).mean(-1, keepdims=True)
    y = (xf - mu) * lax.rsqrt(var + LN_EPS)
    return (y * g.astype(jnp.float32) + b.astype(jnp.float32)).astype(x.dtype)


def masked_softmax(s, mask):
    s = jnp.where(mask, s.astype(jnp.float32), NEG)
    m = s.max(-1, keepdims=True)
    e = jnp.where(mask, jnp.exp(s - m), 0.0)
    return e / jnp.maximum(e.sum(-1, keepdims=True), 1e-30)


def rope_tables(seq):
    inv = ROPE_THETA ** (-jnp.arange(0, ROPE_DIM, 2, dtype=jnp.float32) / ROPE_DIM)
    ang = jnp.arange(seq, dtype=jnp.float32)[:, None] * inv[None, :]
    return jnp.cos(ang), jnp.sin(ang)


def partial_rope(x, cos, sin):
    half = ROPE_DIM // 2
    shape = (cos.shape[0],) + (1,) * (x.ndim - 3) + (half,)
    c = cos.reshape(shape).astype(x.dtype)
    s = sin.reshape(shape).astype(x.dtype)
    x1, x2, rest = x[..., :half], x[..., half:ROPE_DIM], x[..., ROPE_DIM:]
    return jnp.concatenate([x1 * c - x2 * s, x2 * c + x1 * s, rest], axis=-1)


def short_conv_mixer(h, b_gate, c_gate, conv_w):
    u = c_gate * h
    y = lax.conv_general_dilated(u, conv_w, window_strides=(1,),
                                 padding=[(CONV_WIDTH - 1, 0)],
                                 dimension_numbers=('NWC', 'WIO', 'NWC'),
                                 feature_group_count=CONV_DIM)
    return b_gate * y


def compress(kv, pe, w1, w2):
    nc = (kv.shape[1] - CMP_BLOCK) // CMP_STRIDE + 1
    idx = jnp.arange(nc)[:, None] * CMP_STRIDE + jnp.arange(CMP_BLOCK)[None, :]
    blocks = kv[:, idx] + pe[:, None, :].astype(kv.dtype)
    hid = jax.nn.gelu(jnp.einsum('bnlgd,ldh->bngh', blocks, w1))
    return jnp.einsum('bngh,hd->bngd', hid, w2)


def cmp_to_sel_matrix(nc, ns):
    start = np.arange(nc)[:, None] * CMP_STRIDE
    s0 = np.arange(ns)[None, :] * SEL_BLOCK
    return jnp.asarray(((start < s0 + SEL_BLOCK) & (start + CMP_BLOCK > s0)).astype(np.float32))


def nsa_attention(q, k_cmp, v_cmp, k_sel, v_sel, k_win, v_win, gate_logits,
                  pe_k, wk1, wk2, pe_v, wv1, wv2, cos, sin):
    B, S = q.shape[0], q.shape[1]
    G, Z, Dh = N_KV_GROUPS, HEADS_PER_GROUP, HEAD_DIM
    scale = Dh ** -0.5
    t = jnp.arange(S)
    q = q.reshape(B, S, G, Z, Dh)
    k_cmp, v_cmp, k_sel, v_sel, k_win, v_win = [
        a.reshape(B, S, G, Dh) for a in (k_cmp, v_cmp, k_sel, v_sel, k_win, v_win)]
    q_rot = partial_rope(q, cos, sin)
    k_sel = partial_rope(k_sel, cos, sin)
    k_win = partial_rope(k_win, cos, sin)

    kc = compress(k_cmp, pe_k, wk1, wk2)
    vc = compress(v_cmp, pe_v, wv1, wv2)
    nc = kc.shape[1]
    s_c = jnp.einsum('bsgzd,bngd->bgzsn', q, kc) * scale
    blk_end = jnp.arange(nc) * CMP_STRIDE + CMP_BLOCK - 1
    p_c = masked_softmax(s_c, blk_end[None, :] <= t[:, None])
    o_cmp = jnp.einsum('bgzsn,bngd->bsgzd', p_c, vc)

    ns = S // SEL_BLOCK
    n_sel = min(N_SEL, ns)
    imp = jnp.einsum('bgzsn,nj->bgsj', p_c, cmp_to_sel_matrix(nc, ns))
    jblk = jnp.arange(ns)[None, :]
    cur = (t // SEL_BLOCK)[:, None]
    forced = (jblk == 0) | (jblk == cur) | (jblk == cur - 1)
    imp = jnp.where(jblk <= cur, jnp.where(forced, FORCE, imp), NEG)
    vals, sel_idx = lax.top_k(imp, n_sel)
    sel_ok = vals > 0.5 * NEG

    kb = k_sel.reshape(B, ns, SEL_BLOCK, G, Dh).transpose(0, 3, 1, 2, 4)
    vb = v_sel.reshape(B, ns, SEL_BLOCK, G, Dh).transpose(0, 3, 1, 2, 4)
    nq = S // SEL_Q_CHUNK
    gather = jax.vmap(jax.vmap(lambda a, i: a[i]))

    def sel_chunk(args):
        qc, ic, okc, tc = args
        kg = gather(kb, ic)
        vg = gather(vb, ic)
        s = jnp.einsum('bcgzd,bgcnld->bgzcnl', qc, kg) * scale
        kpos = ic[..., None] * SEL_BLOCK + jnp.arange(SEL_BLOCK)
        mask = okc[..., None] & (kpos <= tc[:, None, None])
        nk = n_sel * SEL_BLOCK
        p = masked_softmax(s.reshape(B, G, Z, SEL_Q_CHUNK, nk),
                           mask.reshape(B, G, 1, SEL_Q_CHUNK, nk))
        return jnp.einsum('bgzck,bgckd->bcgzd', p, vg.reshape(B, G, SEL_Q_CHUNK, nk, Dh))

    o_sel = lax.map(sel_chunk, (
        q_rot.reshape(B, nq, SEL_Q_CHUNK, G, Z, Dh).transpose(1, 0, 2, 3, 4, 5),
        sel_idx.reshape(B, G, nq, SEL_Q_CHUNK, n_sel).transpose(2, 0, 1, 3, 4),
        sel_ok.reshape(B, G, nq, SEL_Q_CHUNK, n_sel).transpose(2, 0, 1, 3, 4),
        t.reshape(nq, SEL_Q_CHUNK)))
    o_sel = o_sel.transpose(1, 0, 2, 3, 4, 5).reshape(B, S, G, Z, Dh)

    nqb = S // Q_BLOCK
    nb = WINDOW // Q_BLOCK + 1

    def band(a):
        ap = jnp.pad(a, ((0, 0), (WINDOW, 0), (0, 0), (0, 0)))
        ab = ap.reshape(B, (S + WINDOW) // Q_BLOCK, Q_BLOCK, G, Dh)
        return jnp.concatenate([ab[:, j:j + nqb] for j in range(nb)], axis=2)

    kw = band(k_win)
    vw = band(v_win)
    qw = q_rot.reshape(B, nqb, Q_BLOCK, G, Z, Dh)
    s_w = jnp.einsum('biqgzd,bikgd->bgziqk', qw, kw) * scale
    qpos = t.reshape(nqb, Q_BLOCK)
    kpos = jnp.arange(nqb)[:, None] * Q_BLOCK - WINDOW + jnp.arange(nb * Q_BLOCK)[None, :]
    diff = qpos[:, :, None] - kpos[:, None, :]
    wmask = (kpos[:, None, :] >= 0) & (diff >= 0) & (diff < WINDOW)
    p_w = masked_softmax(s_w, wmask)
    o_win = jnp.einsum('bgziqk,bikgd->biqgzd', p_w, vw).reshape(B, S, G, Z, Dh)

    g = jax.nn.sigmoid(gate_logits.astype(jnp.float32)).reshape(B, S, G, Z, N_NSA_BRANCHES)
    o = g[..., 0:1] * o_cmp + g[..., 1:2] * o_sel + g[..., 2:3] * o_win
    return o.reshape(B, S, NSA_DIM).astype(q.dtype)


def hybrid_layer(x, w_in, conv_w, w_conv_out, pe_k_cmp, w_k_cmp1, w_k_cmp2,
                 pe_v_cmp, w_v_cmp1, w_v_cmp2, w_nsa_out, w_o, ln1_g, ln1_b,
                 w_up, w_down, ln2_g, ln2_b, cos, sin):
    proj = x @ w_in
    offs = np.cumsum(IN_SPLITS)[:-1].tolist()
    (h, b_gate, c_gate, q, k_cmp, v_cmp, k_sel, v_sel, k_win, v_win,
     nsa_gates, g_conv, g_nsa) = jnp.split(proj, offs, axis=-1)
    y_conv = short_conv_mixer(h, b_gate, c_gate, conv_w) @ w_conv_out
    y_nsa = nsa_attention(q, k_cmp, v_cmp, k_sel, v_sel, k_win, v_win, nsa_gates,
                          pe_k_cmp, w_k_cmp1, w_k_cmp2, pe_v_cmp, w_v_cmp1, w_v_cmp2,
                          cos, sin) @ w_nsa_out
    mixed = jax.nn.sigmoid(g_conv) * y_conv + jax.nn.sigmoid(g_nsa) * y_nsa
    x = layer_norm(ALPHA * x + mixed @ w_o, ln1_g, ln1_b)
    ff = jnp.square(jax.nn.relu(x @ w_up)) @ w_down
    return layer_norm(ALPHA * x + ff, ln2_g, ln2_b)


def setup_inputs(seed: int = 0) -> dict:
    key = jax.random.key(seed)
    ks = jax.random.split(key, 20)
    nrm = lambda k, shape, s: jax.random.normal(k, shape, jnp.float32) * s
    L = DEPTH
    return {
        "x": nrm(ks[0], (BATCH, SEQ, D_MODEL), 1.0),
        "w_in": nrm(ks[1], (L, D_MODEL, N_IN), D_MODEL ** -0.5),
        "conv_w": nrm(ks[2], (L, CONV_WIDTH, 1, CONV_DIM), CONV_WIDTH ** -0.5),
        "w_conv_out": nrm(ks[3], (L, CONV_DIM, D_MODEL), CONV_DIM ** -0.5),
        "pe_k_cmp": nrm(ks[4], (L, CMP_BLOCK, HEAD_DIM), 0.5),
        "w_k_cmp1": nrm(ks[5], (L, CMP_BLOCK, HEAD_DIM, CMP_HIDDEN), (CMP_BLOCK * HEAD_DIM) ** -0.5),
        "w_k_cmp2": nrm(ks[6], (L, CMP_HIDDEN, HEAD_DIM), CMP_HIDDEN ** -0.5),
        "pe_v_cmp": nrm(ks[7], (L, CMP_BLOCK, HEAD_DIM), 0.5),
        "w_v_cmp1": nrm(ks[8], (L, CMP_BLOCK, HEAD_DIM, CMP_HIDDEN), (CMP_BLOCK * HEAD_DIM) ** -0.5),
        "w_v_cmp2": nrm(ks[9], (L, CMP_HIDDEN, HEAD_DIM), CMP_HIDDEN ** -0.5),
        "w_nsa_out": nrm(ks[10], (L, NSA_DIM, D_MODEL), NSA_DIM ** -0.5),
        "w_o": nrm(ks[11], (L, D_MODEL, D_MODEL), BETA * D_MODEL ** -0.5),
        "ln1_g": 1.0 + nrm(ks[12], (L, D_MODEL), 0.02),
        "ln1_b": nrm(ks[13], (L, D_MODEL), 0.02),
        "w_up": nrm(ks[14], (L, D_MODEL, D_FF), D_MODEL ** -0.5),
        "w_down": nrm(ks[15], (L, D_FF, D_MODEL), BETA * D_FF ** -0.5),
        "ln2_g": 1.0 + nrm(ks[16], (L, D_MODEL), 0.02),
        "ln2_b": nrm(ks[17], (L, D_MODEL), 0.02),
    }


def reference(x, w_in, conv_w, w_conv_out, pe_k_cmp, w_k_cmp1, w_k_cmp2,
              pe_v_cmp, w_v_cmp1, w_v_cmp2, w_nsa_out, w_o, ln1_g, ln1_b,
              w_up, w_down, ln2_g, ln2_b):
    cos, sin = rope_tables(x.shape[1])
    for l in range(DEPTH):
        x = hybrid_layer(x, w_in[l], conv_w[l], w_conv_out[l], pe_k_cmp[l], w_k_cmp1[l],
                         w_k_cmp2[l], pe_v_cmp[l], w_v_cmp1[l], w_v_cmp2[l], w_nsa_out[l],
                         w_o[l], ln1_g[l], ln1_b[l], w_up[l], w_down[l], ln2_g[l], ln2_b[l],
                         cos, sin)
    return x
```

```cpp
#include <hip/hip_runtime.h>
#include <hip/hip_cooperative_groups.h>
#include <cstdio>
#include <cstdint>
namespace cg = cooperative_groups;
namespace pg8 {
#define PG8_LAS __attribute__((address_space(3)))
typedef unsigned short bf16_t;
typedef short bf16x8 __attribute__((ext_vector_type(8)));
typedef float f32x4 __attribute__((ext_vector_type(4)));
typedef unsigned u32x4 __attribute__((ext_vector_type(4)));
constexpr int BM = 256, BK = 64, HALF = 128, HTB = HALF * BK * 2  , STAGE_BYTES = 8 * HTB, NXCD = 8, WGM = 8;

__host__ __device__ __forceinline__ int lds_byte(int r, int c) { const int st = (r >> 4) * 2 + (c >> 5), rr = r & 15, cc = c & 31, ob = rr * 64 + cc * 2; return st * 1024 + (ob ^ (((ob >> 9) & 1) << 5)); }
__host__ __device__ __forceinline__ void stage_rc(int b, int& R, int& C) { const int st = b / 1024, sb = b % 1024, swz = sb ^ (((sb >> 9) & 1) << 5); R = (st >> 1) * 16 + swz / 64; C = (st & 1) * 32 + (swz % 64) / 2; }
__host__ __device__ __forceinline__ int perm32(int rho) { const int n = rho >> 4, i = rho & 15; return 8 * (i >> 2) + 4 * n + (i & 3); }

struct Unit { int pm, pn; };
struct Gemm { const bf16_t* A; const bf16_t* Bt; int M, N, K; };

struct StaticOrder {
    int nM, nN, nwg, G, c;
    __host__ __device__ void init(int M, int N, int G_, int c_) { nM = M / BM; nN = N / BM; nwg = nM * nN; G = G_; c = c_; }
    __host__ __device__ bool next(int i, Unit& u) const {
        const long L = (long)i * G + c; if (L >= nwg) return false;
        int wgid = (int)L; { const int q = nwg / NXCD, r = nwg % NXCD, xcd = wgid % NXCD, off = wgid / NXCD; wgid = (xcd < r ? xcd * (q + 1) : r * (q + 1) + (xcd - r) * q) + off; }
        const int nig = WGM * nN, gid = wgid / nig, fm = gid * WGM, gsz = (nM - fm) < WGM ? (nM - fm) : WGM;
        u.pm = fm + ((wgid % nig) % gsz); u.pn = (wgid % nig) / gsz; return true;
    }
    __device__ __forceinline__ void a_ready(const Unit&) const {}
    __device__ __forceinline__ void done(const Unit&) const {}
};

__device__ __forceinline__ unsigned cvt_pk_bf16(float lo, float hi) { unsigned r; asm volatile("v_cvt_pk_bf16_f32 %0, %1, %2" : "=v"(r) : "v"(lo), "v"(hi)); return r; }
typedef float f32x2 __attribute__((ext_vector_type(2)));
template <class Epi, class Sched, bool ALIGN_EPI = false, bool SP2 = false>
__device__ __forceinline__ void gemm_phase(PG8_LAS unsigned char* lds, const Gemm g, const Sched& S, const Epi& E) {
    const int tid = threadIdx.x, wid = __builtin_amdgcn_readfirstlane(tid >> 6), lane = tid & 63, wr = wid >> 2, wc = wid & 3, fr = lane & 15, fq = lane >> 4;
    const int K = g.K, nt = K / BK;
    unsigned voffA[2], voffB[2];
#pragma unroll
    for (int i = 0; i < 2; ++i) { int R, C; stage_rc(tid * 16 + i * 8192, R, C); const int Rb = Epi::PERM ? ((R & ~31) + perm32(R & 31)) : R;
        voffA[i] = (unsigned)(R * K + C) * 2u; voffB[i] = (unsigned)(Rb * K + C) * 2u; }
    const size_t kstep = (size_t)(BK * 2);
    const size_t hstep = (size_t)HALF * K * 2;
    const size_t tstep = 2 * hstep;
    const unsigned ldsw = (unsigned)wid * 1024u;
    const int aoff = lds_byte(wr * 64 + fr, fq * 8), boff = lds_byte(wc * 32 + fr, fq * 8);
#define PG8_SA(b, h) (((b) * 2 + (h)) * HTB)
#define PG8_SB(b, h) ((4 + (b) * 2 + (h)) * HTB)
#define PG8_STAGE(bufoff, gbase, voff) do { _Pragma("unroll") for (int _i = 0; _i < 2; ++_i) \
        __builtin_amdgcn_global_load_lds((const unsigned*)((const char*)(gbase) + (voff)[_i]), (PG8_LAS unsigned*)(lds + (bufoff) + ldsw + _i * 8192), 16, 0, 0); } while (0)
#define PG8_LDA(dst, b, h) do { _Pragma("unroll") for (int m = 0; m < 4; ++m) _Pragma("unroll") for (int k = 0; k < 2; ++k) dst[m][k] = *(const PG8_LAS bf16x8*)(lds + PG8_SA(b, h) + aoff + m * 2048 + k * 1024); } while (0)
#define PG8_LDB(dst, b, h) do { _Pragma("unroll") for (int n = 0; n < 2; ++n) _Pragma("unroll") for (int k = 0; k < 2; ++k) dst[n][k] = *(const PG8_LAS bf16x8*)(lds + PG8_SB(b, h) + boff + n * 2048 + k * 1024); } while (0)
#define PG8_MMA(ai, bj, At, Bt) do { __builtin_amdgcn_s_setprio(1); _Pragma("unroll") for (int m = 0; m < 4; ++m) _Pragma("unroll") for (int n = 0; n < 2; ++n) _Pragma("unroll") for (int k = 0; k < 2; ++k) \
        acc[ai][bj][m][n] = __builtin_amdgcn_mfma_f32_16x16x32_bf16(Bt[n][k], At[m][k], acc[ai][bj][m][n], 0, 0, 0); __builtin_amdgcn_s_setprio(0); } while (0)
#define PG8_WAIT_V(n) asm volatile("s_waitcnt vmcnt(" #n ")" ::: "memory")
#define PG8_WAIT_L(n) asm volatile("s_waitcnt lgkmcnt(" #n ")" ::: "memory")
#define PG8_BAR __builtin_amdgcn_s_barrier()
#define PG8_SCHED __builtin_amdgcn_sched_barrier(0)
    Unit cur, nxt; int ui = 0;
    if (!S.next(0, cur)) return;
    f32x4 acc[2][2][4][2];
#pragma unroll
    for (int a = 0; a < 2; ++a)
#pragma unroll
        for (int b = 0; b < 2; ++b)
#pragma unroll
            for (int m = 0; m < 4; ++m)
#pragma unroll
                for (int n = 0; n < 2; ++n) acc[a][b][m][n] = (f32x4){0.f, 0.f, 0.f, 0.f};
    bf16x8 At[4][2], B0[2][2], B1[2][2];
    const char* cA = (const char*)g.A + (size_t)cur.pm * tstep; const char* cB = (const char*)g.Bt + (size_t)cur.pn * tstep;
    S.a_ready(cur);
    if constexpr (SP2) {
        PG8_STAGE(PG8_SB(0, 0), cB, voffB); PG8_STAGE(PG8_SB(0, 1), cB + hstep, voffB); PG8_STAGE(PG8_SA(0, 0), cA, voffA); PG8_STAGE(PG8_SA(0, 1), cA + hstep, voffA);
        if (wr == 1) PG8_BAR;
        PG8_WAIT_V(2); PG8_BAR;
        PG8_STAGE(PG8_SB(1, 0), cB + kstep, voffB); PG8_STAGE(PG8_SA(1, 0), cA + kstep, voffA); PG8_STAGE(PG8_SB(1, 1), cB + hstep + kstep, voffB);
        PG8_WAIT_V(6); PG8_BAR;
    } else {
        PG8_STAGE(PG8_SB(0, 0), cB, voffB); PG8_STAGE(PG8_SA(0, 0), cA, voffA); PG8_STAGE(PG8_SB(0, 1), cB + hstep, voffB); PG8_STAGE(PG8_SA(0, 1), cA + hstep, voffA);
        if (wr == 1) PG8_BAR;
        PG8_WAIT_V(4); PG8_BAR;
        PG8_STAGE(PG8_SB(1, 0), cB + kstep, voffB); PG8_STAGE(PG8_SA(1, 0), cA + kstep, voffA); PG8_STAGE(PG8_SB(1, 1), cB + hstep + kstep, voffB);
        PG8_WAIT_V(6); PG8_BAR;
    }
    for (;;) {
        const bool has_next = S.next(ui + 1, nxt);
        const char* nA = has_next ? (const char*)g.A + (size_t)nxt.pm * tstep : cA; const char* nB = has_next ? (const char*)g.Bt + (size_t)nxt.pn * tstep : cB;
        for (int t = 0; t < nt; t += 2) {
            const bool last = (t == nt - 2);
            const char* a1 = cA + (size_t)(t + 1) * kstep;
            const char* a2 = last ? nA : cA + (size_t)(t + 2) * kstep; const char* b2 = last ? nB : cB + (size_t)(t + 2) * kstep;
            const char* a3 = a2 + kstep; const char* b3 = b2 + kstep;
            if (last && has_next) S.a_ready(nxt);
            if constexpr (SP2) {
            PG8_LDB(B0, 0, 0); PG8_LDB(B1, 0, 1); PG8_SCHED; PG8_LDA(At, 0, 0); PG8_STAGE(PG8_SA(1, 1), a1 + hstep, voffA);
            PG8_WAIT_V(8); PG8_WAIT_L(0); PG8_BAR; PG8_MMA(0, 0, At, B0); PG8_MMA(0, 1, At, B1); PG8_BAR; PG8_SCHED;
            PG8_LDA(At, 0, 1); PG8_STAGE(PG8_SB(0, 0), b2, voffB); PG8_STAGE(PG8_SB(0, 1), b2 + hstep, voffB); PG8_STAGE(PG8_SA(0, 0), a2, voffA);
            PG8_WAIT_V(8); PG8_WAIT_L(0); PG8_BAR; PG8_MMA(1, 0, At, B0); PG8_MMA(1, 1, At, B1); PG8_BAR; PG8_SCHED;
            PG8_LDB(B0, 1, 0); PG8_LDB(B1, 1, 1); PG8_SCHED; PG8_LDA(At, 1, 0); PG8_STAGE(PG8_SA(0, 1), a2 + hstep, voffA);
            PG8_WAIT_V(8); PG8_WAIT_L(0); PG8_BAR; PG8_MMA(0, 0, At, B0); PG8_MMA(0, 1, At, B1); PG8_BAR; PG8_SCHED;
            PG8_LDA(At, 1, 1); PG8_STAGE(PG8_SB(1, 0), b3, voffB); PG8_STAGE(PG8_SB(1, 1), b3 + hstep, voffB); PG8_STAGE(PG8_SA(1, 0), a3, voffA);
            PG8_WAIT_V(8); PG8_WAIT_L(0); PG8_BAR; PG8_MMA(1, 0, At, B0); PG8_MMA(1, 1, At, B1); PG8_BAR; PG8_SCHED;
            } else {
            PG8_LDB(B0, 0, 0); PG8_SCHED; PG8_LDA(At, 0, 0); PG8_STAGE(PG8_SA(1, 1), a1 + hstep, voffA);
            PG8_WAIT_L(8); PG8_BAR; PG8_WAIT_L(0); PG8_MMA(0, 0, At, B0); PG8_BAR; PG8_SCHED;
            PG8_LDB(B1, 0, 1); PG8_STAGE(PG8_SB(0, 0), b2, voffB);
            PG8_BAR; PG8_WAIT_L(0); PG8_MMA(0, 1, At, B1); PG8_BAR;
            PG8_LDA(At, 0, 1); PG8_STAGE(PG8_SA(0, 0), a2, voffA);
            PG8_BAR; PG8_WAIT_L(0); PG8_MMA(1, 0, At, B0); PG8_BAR; PG8_SCHED;
            PG8_STAGE(PG8_SB(0, 1), b2 + hstep, voffB);
            PG8_WAIT_V(6); PG8_BAR; PG8_MMA(1, 1, At, B1); PG8_BAR;
            PG8_LDB(B0, 1, 0); PG8_SCHED; PG8_LDA(At, 1, 0); PG8_STAGE(PG8_SA(0, 1), a2 + hstep, voffA);
            PG8_WAIT_L(8); PG8_BAR; PG8_WAIT_L(0); PG8_MMA(0, 0, At, B0); PG8_BAR; PG8_SCHED;
            PG8_LDB(B1, 1, 1); PG8_STAGE(PG8_SB(1, 0), b3, voffB);
            PG8_BAR; PG8_WAIT_L(0); PG8_MMA(0, 1, At, B1); PG8_BAR;
            PG8_LDA(At, 1, 1); PG8_STAGE(PG8_SA(1, 0), a3, voffA);
            PG8_BAR; PG8_WAIT_L(0); PG8_MMA(1, 0, At, B0); PG8_BAR; PG8_SCHED;
            PG8_STAGE(PG8_SB(1, 1), b3 + hstep, voffB);
            PG8_WAIT_V(6); PG8_BAR; PG8_MMA(1, 1, At, B1); PG8_BAR;
            }
        }
        if constexpr (ALIGN_EPI) { if (wr == 0) PG8_BAR; }
        if constexpr (!Epi::AFTER_DRAIN) { E(acc, cur, wr, wc, fr, fq); S.done(cur); }
        if (!has_next) break;
#pragma unroll
        for (int a = 0; a < 2; ++a)
#pragma unroll
            for (int b = 0; b < 2; ++b)
#pragma unroll
                for (int m = 0; m < 4; ++m)
#pragma unroll
                    for (int n = 0; n < 2; ++n) acc[a][b][m][n] = (f32x4){0.f, 0.f, 0.f, 0.f};
        cur = nxt; cA = nA; cB = nB; ++ui;
        if constexpr (ALIGN_EPI) { if (wr == 1) PG8_BAR; }
    }
    PG8_WAIT_V(0);
    if constexpr (!ALIGN_EPI) { if (wr == 0) PG8_BAR; }
    PG8_BAR;
    if constexpr (Epi::AFTER_DRAIN) { E.fused(acc, cur, wr, wc, fr, fq, lds, wid, lane); S.done(cur); }
#undef PG8_SA
#undef PG8_SB
#undef PG8_STAGE
#undef PG8_LDA
#undef PG8_LDB
#undef PG8_MMA
#undef PG8_WAIT_V
#undef PG8_WAIT_L
#undef PG8_BAR
#undef PG8_SCHED
}
}

#define LAS __attribute__((address_space(3)))
typedef unsigned short bf16;
typedef unsigned u32x4 __attribute__((ext_vector_type(4)));
typedef unsigned u32x2 __attribute__((ext_vector_type(2)));
typedef float f32x4 __attribute__((ext_vector_type(4)));
typedef float f32x16 __attribute__((ext_vector_type(16)));
typedef short bf16x8 __attribute__((ext_vector_type(8)));
typedef short s16x4 __attribute__((ext_vector_type(4)));

constexpr int M = 16384, DM = 1024, SEQ = 2048, FF = 4096, NINP = 5120, NIN = 4888;
constexpr float ALPHA = 1.189207115002721f;
constexpr float LN_EPS = 1e-5f;
constexpr int LDS_BYTES = 147456;
constexpr size_t MiB = 1u << 20;
constexpr size_t WS_ROPE = 0, WS_CBIAS = 256 * 1024;
constexpr size_t WS_W1T = 1 * MiB, WS_W2T = 2 * MiB, WS_KC = 2 * MiB + 512 * 1024, WS_VC = WS_KC + 256 * 1024;
constexpr size_t WS_WIN = 4 * MiB, WS_WCONV = 14 * MiB, WS_WNSA = 15 * MiB, WS_WO = 16 * MiB, WS_WUP = 18 * MiB, WS_WDOWN = 26 * MiB;
constexpr size_t WS_XB = 34 * MiB;
constexpr size_t WS_HBC = 66 * MiB;
constexpr size_t WS_O = 66 * MiB;
constexpr size_t WS_T1 = 82 * MiB;
constexpr size_t WS_Q = 114 * MiB, WS_QR = 130 * MiB, WS_KV = 146 * MiB, WS_GT = 170 * MiB, WS_GC = 172 * MiB, WS_GN = 204 * MiB, WS_MIX1 = 236 * MiB;
constexpr size_t WS_HB = 66 * MiB;

struct Params {
    const float *x, *w_in, *conv_w, *w_conv_out, *pe_k, *w_k1, *w_k2, *pe_v, *w_v1, *w_v2, *w_nsa_out, *w_o, *ln1_g, *ln1_b, *w_up, *w_down, *ln2_g, *ln2_b;
    float* out; unsigned char* ws;
};

__device__ __forceinline__ unsigned f2bf(float f) { unsigned u = __builtin_bit_cast(unsigned, f); return (u + 0x7fffu + ((u >> 16) & 1u)) >> 16; }
__device__ __forceinline__ unsigned pk2(float lo, float hi) { return pg8::cvt_pk_bf16(lo, hi); }
__device__ __forceinline__ float bflo(unsigned w) { return __builtin_bit_cast(float, w << 16); }
__device__ __forceinline__ float bfhi(unsigned w) { return __builtin_bit_cast(float, w & 0xffff0000u); }
__device__ __forceinline__ float sigm(float v) { return 1.f / (1.f + __expf(-v)); }
__device__ __forceinline__ float wave_sum(float v) {
#pragma unroll
    for (int o = 1; o < 64; o <<= 1) v += __shfl_xor(v, o);
    return v;
}
#define LDS_WAIT() asm volatile("s_waitcnt lgkmcnt(0)" ::: "memory")

namespace pg8 {
struct EpiProj {
    static constexpr bool PERM = true, AFTER_DRAIN = false;
    bf16_t *HBC, *Q, *QR, *KV, *GC, *GN; float* GT; const float* rope;
    __device__ __forceinline__ void operator()(const f32x4 (&acc)[2][2][4][2], const Unit& u, int wr, int wc, int fr, int fq) const {
        const int pn = u.pn; const int row0 = u.pm * BM + wr * 64 + fr; const int cl = wc * 32 + 8 * fq;
        const bool ropew = ((wc & 1) == 0);
#pragma unroll
        for (int ai = 0; ai < 2; ++ai)
#pragma unroll
            for (int m = 0; m < 4; ++m) {
                const int row = row0 + ai * HALF + m * 16;
#pragma unroll
                for (int bj = 0; bj < 2; ++bj) {
                    f32x4 v0 = acc[ai][bj][m][0], v1 = acc[ai][bj][m][1];
                    const int ct = bj * HALF + cl;
                    if (pn < 6) {
                        u32x4 w; w.x = cvt_pk_bf16(v0[0], v0[1]); w.y = cvt_pk_bf16(v0[2], v0[3]); w.z = cvt_pk_bf16(v1[0], v1[1]); w.w = cvt_pk_bf16(v1[2], v1[3]);
                        *(u32x4*)(HBC + (size_t)row * 1536 + pn * 256 + ct) = w;
                    } else if (pn < 11) {
                        const bool isq = pn < 8;
                        if (isq) { u32x4 w; w.x = cvt_pk_bf16(v0[0], v0[1]); w.y = cvt_pk_bf16(v0[2], v0[3]); w.z = cvt_pk_bf16(v1[0], v1[1]); w.w = cvt_pk_bf16(v1[2], v1[3]);
                            *(u32x4*)(Q + (size_t)row * 512 + (pn - 6) * 256 + ct) = w; }
                        const bool dorope = ropew && (isq || (pn >= 9 && bj == 0));
                        if (dorope) {
                            const float* rp = rope + (size_t)(row & (SEQ - 1)) * 16;
                            const f32x4 c0 = *(const f32x4*)(rp), c1 = *(const f32x4*)(rp + 4), s0 = *(const f32x4*)(rp + 8), s1 = *(const f32x4*)(rp + 12);
                            f32x4 o0, o1;
#pragma unroll
                            for (int e = 0; e < 4; ++e) { o0[e] = __shfl_xor(v0[e], 16); o1[e] = __shfl_xor(v1[e], 16); }
                            if (fq == 0) { v0 = v0 * c0 - o0 * s0; v1 = v1 * c1 - o1 * s1; }
                            else if (fq == 1) { v0 = v0 * c0 + o0 * s0; v1 = v1 * c1 + o1 * s1; }
                        }
                        u32x4 w; w.x = cvt_pk_bf16(v0[0], v0[1]); w.y = cvt_pk_bf16(v0[2], v0[3]); w.z = cvt_pk_bf16(v1[0], v1[1]); w.w = cvt_pk_bf16(v1[2], v1[3]);
                        if (isq) *(u32x4*)(QR + (size_t)row * 512 + (pn - 6) * 256 + ct) = w;
                        else *(u32x4*)(KV + (size_t)row * 768 + (pn - 8) * 256 + ct) = w;
                    } else if (pn < 19) {
#pragma unroll
                        for (int e = 0; e < 4; ++e) { v0[e] = sigm(v0[e]); v1[e] = sigm(v1[e]); }
                        u32x4 w; w.x = cvt_pk_bf16(v0[0], v0[1]); w.y = cvt_pk_bf16(v0[2], v0[3]); w.z = cvt_pk_bf16(v1[0], v1[1]); w.w = cvt_pk_bf16(v1[2], v1[3]);
                        bf16_t* dst = (pn < 15) ? GC + (size_t)row * 1024 + (pn - 11) * 256 + ct : GN + (size_t)row * 1024 + (pn - 15) * 256 + ct;
                        *(u32x4*)dst = w;
                    } else {
                        if (bj == 0 && wc == 0) {
#pragma unroll
                            for (int e = 0; e < 4; ++e) { v0[e] = sigm(v0[e]); v1[e] = sigm(v1[e]); }
                            *(f32x4*)(GT + (size_t)row * 32 + cl) = v0; *(f32x4*)(GT + (size_t)row * 32 + cl + 4) = v1;
                        }
                    }
                }
            }
    }
};
struct EpiGate1 {
    static constexpr bool PERM = true, AFTER_DRAIN = false;
    const bf16_t* G; float* T1;
    __device__ __forceinline__ void operator()(const f32x4 (&acc)[2][2][4][2], const Unit& u, int wr, int wc, int fr, int fq) const {
        const int row0 = u.pm * BM + wr * 64 + fr; const int col0 = u.pn * BM + wc * 32 + 8 * fq;
#pragma unroll
        for (int ai = 0; ai < 2; ++ai)
#pragma unroll
            for (int m = 0; m < 4; ++m) { const size_t off = (size_t)(row0 + ai * HALF + m * 16) * 1024 + col0;
#pragma unroll
                for (int bj = 0; bj < 2; ++bj) { const u32x4 g = *(const u32x4*)(G + off + bj * HALF); const f32x4 v0 = acc[ai][bj][m][0], v1 = acc[ai][bj][m][1];
                    f32x4 o0, o1; o0[0] = v0[0] * bflo(g.x); o0[1] = v0[1] * bfhi(g.x); o0[2] = v0[2] * bflo(g.y); o0[3] = v0[3] * bfhi(g.y);
                    o1[0] = v1[0] * bflo(g.z); o1[1] = v1[1] * bfhi(g.z); o1[2] = v1[2] * bflo(g.w); o1[3] = v1[3] * bfhi(g.w);
                    *(f32x4*)(T1 + off + bj * HALF) = o0; *(f32x4*)(T1 + off + bj * HALF + 4) = o1; } }
    }
};
struct EpiGate2 {
    static constexpr bool PERM = true, AFTER_DRAIN = false;
    const bf16_t* G; const float* T1; bf16_t* O;
    __device__ __forceinline__ void operator()(const f32x4 (&acc)[2][2][4][2], const Unit& u, int wr, int wc, int fr, int fq) const {
        const int row0 = u.pm * BM + wr * 64 + fr; const int col0 = u.pn * BM + wc * 32 + 8 * fq;
#pragma unroll
        for (int ai = 0; ai < 2; ++ai)
#pragma unroll
            for (int m = 0; m < 4; ++m) { const size_t off = (size_t)(row0 + ai * HALF + m * 16) * 1024 + col0;
#pragma unroll
                for (int bj = 0; bj < 2; ++bj) { const u32x4 g = *(const u32x4*)(G + off + bj * HALF); const f32x4 v0 = acc[ai][bj][m][0], v1 = acc[ai][bj][m][1];
                    const f32x4 t0 = *(const f32x4*)(T1 + off + bj * HALF), t1 = *(const f32x4*)(T1 + off + bj * HALF + 4);
                    f32x4 o0, o1; o0[0] = t0[0] + v0[0] * bflo(g.x); o0[1] = t0[1] + v0[1] * bfhi(g.x); o0[2] = t0[2] + v0[2] * bflo(g.y); o0[3] = t0[3] + v0[3] * bfhi(g.y);
                    o1[0] = t1[0] + v1[0] * bflo(g.z); o1[1] = t1[1] + v1[1] * bfhi(g.z); o1[2] = t1[2] + v1[2] * bflo(g.w); o1[3] = t1[3] + v1[3] * bfhi(g.w);
                    u32x4 w; w.x = cvt_pk_bf16(o0[0], o0[1]); w.y = cvt_pk_bf16(o0[2], o0[3]); w.z = cvt_pk_bf16(o1[0], o1[1]); w.w = cvt_pk_bf16(o1[2], o1[3]);
                    *(u32x4*)(O + off + bj * HALF) = w; } }
    }
};
struct EpiRes {
    static constexpr bool PERM = false, AFTER_DRAIN = false;
    const float* base; float* out;
    __device__ __forceinline__ void operator()(const f32x4 (&acc)[2][2][4][2], const Unit& u, int wr, int wc, int fr, int fq) const {
        const int row0 = u.pm * BM + wr * 64 + fr; const int col0 = u.pn * BM + wc * 32 + 4 * fq;
#pragma unroll
        for (int ai = 0; ai < 2; ++ai)
#pragma unroll
            for (int m = 0; m < 4; ++m) { const size_t off = (size_t)(row0 + ai * HALF + m * 16) * 1024 + col0;
#pragma unroll
                for (int bj = 0; bj < 2; ++bj)
#pragma unroll
                    for (int n = 0; n < 2; ++n) { const f32x4 b = *(const f32x4*)(base + off + bj * HALF + n * 16); *(f32x4*)(out + off + bj * HALF + n * 16) = b * ALPHA + acc[ai][bj][m][n]; } }
    }
};
struct EpiUp {
    static constexpr bool PERM = true, AFTER_DRAIN = false;
    bf16_t* O;
    __device__ __forceinline__ void operator()(const f32x4 (&acc)[2][2][4][2], const Unit& u, int wr, int wc, int fr, int fq) const {
        const int row0 = u.pm * BM + wr * 64 + fr; const int col0 = u.pn * BM + wc * 32 + 8 * fq;
#pragma unroll
        for (int ai = 0; ai < 2; ++ai)
#pragma unroll
            for (int m = 0; m < 4; ++m) { const size_t off = (size_t)(row0 + ai * HALF + m * 16) * FF + col0;
#pragma unroll
                for (int bj = 0; bj < 2; ++bj) { f32x4 v0 = acc[ai][bj][m][0], v1 = acc[ai][bj][m][1];
#pragma unroll
                    for (int e = 0; e < 4; ++e) { const float a = fmaxf(v0[e], 0.f), b = fmaxf(v1[e], 0.f); v0[e] = a * a; v1[e] = b * b; }
                    u32x4 w; w.x = cvt_pk_bf16(v0[0], v0[1]); w.y = cvt_pk_bf16(v0[2], v0[3]); w.z = cvt_pk_bf16(v1[0], v1[1]); w.w = cvt_pk_bf16(v1[2], v1[3]);
                    *(u32x4*)(O + off + bj * HALF) = w; } }
    }
};
}

template <int MODE>
__device__ __forceinline__ void p0_transpose_item(const float* W, int K, int N, int Nd, bf16* WT, LAS float* scr, int item, int lane) {
    const int nblk = Nd / 32, kb = item / nblk, nb = item % nblk, k0 = 64 * kb, n0 = 32 * nb;
    int sc = n0 + (lane & 31); bool ok = true;
    if (MODE == 1) { const int nd = sc; if (nd < 2816) sc = nd; else if (nd < 4864) sc = nd + 24; else if (nd < 4888) sc = nd - 4864 + 2816; else ok = false; }
#pragma unroll 8
    for (int i = 0; i < 32; ++i) { const int kk = 2 * i + (lane >> 5); scr[kk * 33 + (lane & 31)] = ok ? W[(size_t)(k0 + kk) * N + sc] : 0.f; }
    LDS_WAIT();
    const int c = lane & 7;
#pragma unroll
    for (int j = 0; j < 4; ++j) { const int n = (lane >> 3) + 8 * j; const LAS float* s = scr + (8 * c) * 33 + n;
        u32x4 o; o.x = pk2(s[0 * 33], s[1 * 33]); o.y = pk2(s[2 * 33], s[3 * 33]); o.z = pk2(s[4 * 33], s[5 * 33]); o.w = pk2(s[6 * 33], s[7 * 33]);
        *(u32x4*)(WT + (size_t)(n0 + n) * K + k0 + 8 * c) = o; }
    LDS_WAIT();
}

__device__ __forceinline__ void p0_prologue(const Params& p, LAS unsigned char* lds) {
    const int tid = threadIdx.x, lane = tid & 63, wave = tid >> 6;
    LAS float* scr = (LAS float*)(lds + wave * 16384);
    const int gw = blockIdx.x * 8 + wave, NGW = gridDim.x * 8;
    unsigned char* ws = p.ws;
    constexpr int I_IN = 16 * 160, I_CV = 8 * 32, I_NS = 8 * 32, I_O = 16 * 32, I_UP = 16 * 128, I_DN = 64 * 32, I_W1 = 32 * 4, I_W2 = 2 * 2;
    constexpr int NITEMS = I_IN + I_CV + I_NS + I_O + I_UP + I_DN + 2 * I_W1 + 2 * I_W2;
    for (int it = gw; it < NITEMS; it += NGW) {
        int r = it;
        if (r < I_IN) { p0_transpose_item<1>(p.w_in, 1024, NIN, NINP, (bf16*)(ws + WS_WIN), scr, r, lane); continue; } r -= I_IN;
        if (r < I_CV) { p0_transpose_item<0>(p.w_conv_out, 512, 1024, 1024, (bf16*)(ws + WS_WCONV), scr, r, lane); continue; } r -= I_CV;
        if (r < I_NS) { p0_transpose_item<0>(p.w_nsa_out, 512, 1024, 1024, (bf16*)(ws + WS_WNSA), scr, r, lane); continue; } r -= I_NS;
        if (r < I_O) { p0_transpose_item<0>(p.w_o, 1024, 1024, 1024, (bf16*)(ws + WS_WO), scr, r, lane); continue; } r -= I_O;
        if (r < I_UP) { p0_transpose_item<0>(p.w_up, 1024, 4096, 4096, (bf16*)(ws + WS_WUP), scr, r, lane); continue; } r -= I_UP;
        if (r < I_DN) { p0_transpose_item<0>(p.w_down, 4096, 1024, 1024, (bf16*)(ws + WS_WDOWN), scr, r, lane); continue; } r -= I_DN;
        if (r < I_W1) { p0_transpose_item<0>(p.w_k1, 2048, 128, 128, (bf16*)(ws + WS_W1T), scr, r, lane); continue; } r -= I_W1;
        if (r < I_W1) { p0_transpose_item<0>(p.w_v1, 2048, 128, 128, (bf16*)(ws + WS_W1T + 512 * 1024), scr, r, lane); continue; } r -= I_W1;
        if (r < I_W2) { p0_transpose_item<0>(p.w_k2, 128, 64, 64, (bf16*)(ws + WS_W2T), scr, r, lane); continue; } r -= I_W2;
        p0_transpose_item<0>(p.w_v2, 128, 64, 64, (bf16*)(ws + WS_W2T + 16384), scr, r, lane);
    }
    for (int m = gw; m < M; m += NGW) {
        const f32x4* xr = (const f32x4*)(p.x + (size_t)m * DM) + lane; u32x2* o8 = (u32x2*)((bf16*)(ws + WS_XB) + (size_t)m * DM) + lane;
#pragma unroll
        for (int j = 0; j < 4; ++j) { const f32x4 v = xr[64 * j]; u32x2 w; w.x = pk2(v[0], v[1]); w.y = pk2(v[2], v[3]); o8[64 * j] = w; }
    }
    for (int o = gw; o < 256; o += NGW) {
        const int kv = o >> 7, h = o & 127; const float* pe = kv ? p.pe_v : p.pe_k; const float* w1 = kv ? p.w_v1 : p.w_k1;
        float s = 0.f;
        for (int i = lane; i < 2048; i += 64) s += pe[i] * w1[(size_t)i * 128 + h];
        s = wave_sum(s);
        if (lane == 0) ((float*)(ws + WS_CBIAS))[o] = s;
    }
    for (int idx = blockIdx.x * 512 + tid; idx < SEQ * 8; idx += gridDim.x * 512) {
        const int t = idx >> 3, i = idx & 7;
        const float inv = (float)exp2(-(double)i * 0.125 * 18.931568569324174);
        const float ang = (float)t * inv;
        const double a = (double)ang, k = rint(a * 0.15915494309189535), r = (a - k * 6.283185307179586) * 0.15915494309189535;
        const float rev = (float)r;
        ((float*)(ws + WS_ROPE))[t * 16 + i] = __builtin_amdgcn_cosf(rev);
        ((float*)(ws + WS_ROPE))[t * 16 + 8 + i] = __builtin_amdgcn_sinf(rev);
    }
}

__device__ __forceinline__ void unpack8(const u32x4 w, float* o) { o[0] = bflo(w.x); o[1] = bfhi(w.x); o[2] = bflo(w.y); o[3] = bfhi(w.y); o[4] = bflo(w.z); o[5] = bfhi(w.z); o[6] = bflo(w.w); o[7] = bfhi(w.w); }
__device__ __forceinline__ void p2_conv(const Params& p) {
    const bf16* HBC = (const bf16*)(p.ws + WS_HBC); bf16* MIX1 = (bf16*)(p.ws + WS_MIX1);
    for (int it = blockIdx.x * 512 + threadIdx.x; it < M * 64; it += gridDim.x * 512) {
        const int row = it >> 6, ch = (it & 63) * 8, t = row & (SEQ - 1);
        const bf16* r0 = HBC + (size_t)row * 1536 + ch;
        float h0[8], c0[8], bg[8], u1[8], u2[8], tmp[8];
        unpack8(*(const u32x4*)(r0), h0); unpack8(*(const u32x4*)(r0 + 512), bg); unpack8(*(const u32x4*)(r0 + 1024), c0);
        if (t >= 1) { unpack8(*(const u32x4*)(r0 - 1536), u1); unpack8(*(const u32x4*)(r0 - 1536 + 1024), tmp);
#pragma unroll
            for (int e = 0; e < 8; ++e) u1[e] *= tmp[e]; }
        else {
#pragma unroll
            for (int e = 0; e < 8; ++e) u1[e] = 0.f; }
        if (t >= 2) { unpack8(*(const u32x4*)(r0 - 3072), u2); unpack8(*(const u32x4*)(r0 - 3072 + 1024), tmp);
#pragma unroll
            for (int e = 0; e < 8; ++e) u2[e] *= tmp[e]; }
        else {
#pragma unroll
            for (int e = 0; e < 8; ++e) u2[e] = 0.f; }
        const f32x4 wa0 = *(const f32x4*)(p.conv_w + ch), wa1 = *(const f32x4*)(p.conv_w + ch + 4), wb0 = *(const f32x4*)(p.conv_w + 512 + ch), wb1 = *(const f32x4*)(p.conv_w + 512 + ch + 4),
                    wc0 = *(const f32x4*)(p.conv_w + 1024 + ch), wc1 = *(const f32x4*)(p.conv_w + 1024 + ch + 4);
        float y[8];
#pragma unroll
        for (int e = 0; e < 8; ++e) { const float w0 = e < 4 ? wa0[e & 3] : wa1[e & 3], w1 = e < 4 ? wb0[e & 3] : wb1[e & 3], w2 = e < 4 ? wc0[e & 3] : wc1[e & 3];
            y[e] = bg[e] * (w0 * u2[e] + w1 * u1[e] + w2 * (c0[e] * h0[e])); }
        u32x4 w; w.x = pk2(y[0], y[1]); w.y = pk2(y[2], y[3]); w.z = pk2(y[4], y[5]); w.w = pk2(y[6], y[7]);
        *(u32x4*)(MIX1 + (size_t)row * 512 + ch) = w;
    }
}
__device__ __forceinline__ float gelu_tanh(float x) { const float u = 0.7978845608028654f * (x + 0.044715f * x * x * x); const float e = __expf(2.f * u); const float th = 1.f - 2.f / (e + 1.f); return 0.5f * x * (1.f + th); }
__device__ __forceinline__ void p2_compress(const Params& p, LAS unsigned char* lds) {
    const int tid = threadIdx.x, lane = tid & 63, wave = tid >> 6, l15 = lane & 15, kg = lane >> 4;
    LAS bf16* hidL = (LAS bf16*)lds;
    const bf16* KV = (const bf16*)(p.ws + WS_KV);
    for (int u = blockIdx.x; u < 256; u += gridDim.x) {
        const int kv = u >> 7, b = (u >> 4) & 7, g = (u >> 3) & 1, nt = u & 7;
        const bf16* w1t = (const bf16*)(p.ws + WS_W1T + (size_t)kv * 512 * 1024); const bf16* w2t = (const bf16*)(p.ws + WS_W2T + (size_t)kv * 16384);
        const float* bias = (const float*)(p.ws + WS_CBIAS) + kv * 128;
        const int n = nt * 16 + l15;
        const bf16* arow = KV + (size_t)(b * SEQ) * 768 + kv * 128 + g * 64;
        const bf16* brow = w1t + (size_t)(wave * 16 + l15) * 2048 + kg * 8;
        f32x4 acc = {0.f, 0.f, 0.f, 0.f};
#pragma unroll 4
        for (int kk = 0; kk < 64; ++kk) {
            const int k = kk * 32 + kg * 8, l = k >> 6, d = k & 63; int srow = 16 * n + l; srow = srow > SEQ - 1 ? SEQ - 1 : srow;
            const bf16x8 a = *(const bf16x8*)(arow + (size_t)srow * 768 + d);
            const bf16x8 bb = *(const bf16x8*)(brow + kk * 32);
            acc = __builtin_amdgcn_mfma_f32_16x16x32_bf16(a, bb, acc, 0, 0, 0);
        }
        const float bh = bias[wave * 16 + l15];
#pragma unroll
        for (int r = 0; r < 4; ++r) hidL[(4 * kg + r) * 136 + wave * 16 + l15] = (bf16)f2bf(gelu_tanh(acc[r] + bh));
        __syncthreads();
        if (wave < 4) {
            f32x4 o = {0.f, 0.f, 0.f, 0.f};
#pragma unroll
            for (int kk = 0; kk < 4; ++kk) {
                const bf16x8 a = *(const LAS bf16x8*)(hidL + l15 * 136 + kk * 32 + kg * 8);
                const bf16x8 bb = *(const bf16x8*)(w2t + (size_t)(wave * 16 + l15) * 128 + kk * 32 + kg * 8);
                o = __builtin_amdgcn_mfma_f32_16x16x32_bf16(a, bb, o, 0, 0, 0);
            }
            bf16* dst = (bf16*)(p.ws + (kv ? WS_VC : WS_KC)) + (size_t)((b * 2 + g) * 128) * 64;
#pragma unroll
            for (int r = 0; r < 4; ++r) { const int nn = nt * 16 + 4 * kg + r; dst[(size_t)nn * 64 + wave * 16 + l15] = (bf16)(nn < 127 ? f2bf(o[r]) : 0u); }
        }
        __syncthreads();
    }
}

namespace att {
constexpr int L_K = 0, L_V = 16384, L_VC = 32768, L_IMP = 49152, L_TOT = 49152, L_SELM = 114688, L_FAC = 115200;
constexpr float SC = 0.125f * 1.4426950408889634f;
__device__ __forceinline__ constexpr int cr(int r) { return (r & 3) + 8 * (r >> 2); }
typedef short v4i16_t __attribute__((ext_vector_type(4)));
__device__ __forceinline__ s16x4 vtr(const LAS unsigned char* p) { return __builtin_bit_cast(s16x4, __builtin_amdgcn_ds_read_tr16_b64_v4i16((LAS v4i16_t*)p)); }
__device__ __forceinline__ bf16x8 vfrag(const LAS unsigned char* p) { const s16x4 lo = vtr(p), hi = vtr(p + 512); return (bf16x8){lo[0], lo[1], lo[2], lo[3], hi[0], hi[1], hi[2], hi[3]}; }
__device__ __forceinline__ bf16x8 packp(const f32x16& x, int s2) {
    u32x4 w; w.x = pk2(x[8 * s2 + 0], x[8 * s2 + 1]); w.y = pk2(x[8 * s2 + 2], x[8 * s2 + 3]); w.z = pk2(x[8 * s2 + 4], x[8 * s2 + 5]); w.w = pk2(x[8 * s2 + 6], x[8 * s2 + 7]);
    return __builtin_bit_cast(bf16x8, w);
}
__device__ __forceinline__ void pv_sub(f32x16 (&o)[2], const bf16x8 pa0, const bf16x8 pa1, const LAS unsigned char* vt, int sub, int vb) {
#pragma unroll
    for (int dh = 0; dh < 2; ++dh) {
        o[dh] = __builtin_amdgcn_mfma_f32_32x32x16_bf16(pa0, vfrag(vt + vb + dh * 4096 + sub * 2048), o[dh], 0, 0, 0);
        o[dh] = __builtin_amdgcn_mfma_f32_32x32x16_bf16(pa1, vfrag(vt + vb + dh * 4096 + sub * 2048 + 1024), o[dh], 0, 0, 0); }
}

__device__ __forceinline__ void attn_phase(const Params& p, LAS unsigned char* lds) {
    const int tid = threadIdx.x, lane = tid & 63, wid = tid >> 6, r32 = lane & 31, hi = lane >> 5;
    const int z = wid >> 1, qh = wid & 1;
    const bf16* Qb = (const bf16*)(p.ws + WS_Q); const bf16* QRb = (const bf16*)(p.ws + WS_QR); const bf16* KV = (const bf16*)(p.ws + WS_KV);
    const float* GT = (const float*)(p.ws + WS_GT); bf16* Ob = (bf16*)(p.ws + WS_O);
    const bf16* KC = (const bf16*)(p.ws + WS_KC); const bf16* VC = (const bf16*)(p.ws + WS_VC);
    LAS float* fac = (LAS float*)(lds + L_FAC) + wid * 32; LAS float* facl = fac + 4 * hi;
    LAS float* impW = (LAS float*)(lds + L_IMP);
    LAS float* totL = (LAS float*)(lds + L_TOT) + wid * 2048 + lane;
    LAS unsigned* selm = (LAS unsigned*)(lds + L_SELM);
    const int vb = (4 * hi + ((lane & 15) >> 2)) * 64 + ((lane >> 4) & 1) * 32 + (lane & 3) * 8;
    const int vkey = ((tid >> 5) & 7) * 8 + ((tid >> 2) & 7), vd = (tid >> 8) * 32 + (tid & 3) * 8;
    for (int uu = blockIdx.x; uu < 512; uu += gridDim.x) {
        const int bg = (uu & 255) >> 4, qt = (uu < 256) ? (uu & 15) : 31 - (uu & 15);
        const int b = bg >> 1, g = bg & 1, q0 = qt * 64;
        const int qpos = q0 + 32 * qh + r32; const size_t tok = (size_t)b * SEQ + qpos; const int head = g * 4 + z;
#pragma unroll
        for (int T = 0; T < 2; ++T) *(LAS u32x4*)(lds + L_VC + T * 8192 + tid * 16) = *(const u32x4*)(VC + (size_t)(bg * 128 + T * 64 + vkey) * 64 + vd);
        bf16x8 pc[4][2];
        {
            bf16x8 qf[4];
#pragma unroll
            for (int ks = 0; ks < 4; ++ks) qf[ks] = *(const bf16x8*)(Qb + tok * 512 + head * 64 + ks * 16 + hi * 8);
            f32x16 s[4];
#pragma unroll
            for (int sub = 0; sub < 4; ++sub) {
#pragma unroll
                for (int r = 0; r < 16; ++r) s[sub][r] = 0.f;
#pragma unroll
                for (int ks = 0; ks < 4; ++ks) { const bf16x8 kf = *(const bf16x8*)(KC + (size_t)(bg * 128 + sub * 32 + r32) * 64 + ks * 16 + hi * 8);
                    s[sub] = __builtin_amdgcn_mfma_f32_32x32x16_bf16(kf, qf[ks], s[sub], 0, 0, 0); }
            }
            float mx = -1e30f; const int cthr = ((qpos - 31) >> 4) - 4 * hi;
#pragma unroll
            for (int sub = 0; sub < 4; ++sub)
#pragma unroll
                for (int r = 0; r < 16; ++r) { const bool ok = (sub * 32 + cr(r) <= cthr); const float v = ok ? s[sub][r] * SC : -INFINITY; s[sub][r] = v; mx = fmaxf(mx, v); }
            mx = fmaxf(mx, __shfl_xor(mx, 32));
            float l = 0.f;
#pragma unroll
            for (int sub = 0; sub < 4; ++sub)
#pragma unroll
                for (int r = 0; r < 16; ++r) { const float e = __builtin_amdgcn_exp2f(s[sub][r] - mx); s[sub][r] = e; l += e; }
            l += __shfl_xor(l, 32);
            const float linv = 1.f / fmaxf(l, 1e-30f);
#pragma unroll
            for (int sub = 0; sub < 4; ++sub)
#pragma unroll
                for (int r = 0; r < 16; ++r) s[sub][r] *= linv;
            LAS float* iw = impW + (z * 64 + 32 * qh + r32) * 32;
            float prev = 0.f;
#pragma unroll
            for (int i = 0; i < 16; ++i) { const int sub = i >> 2, qd = i & 3;
                const float rv = __shfl_xor(s[sub][4 * qd + 3], 32);
                const float gs = (s[sub][4 * qd] + s[sub][4 * qd + 1]) + (s[sub][4 * qd + 2] + s[sub][4 * qd + 3]);
                iw[8 * sub + 2 * qd + hi] = gs + (hi ? rv : prev); prev = rv; }
#pragma unroll
            for (int sub = 0; sub < 4; ++sub) { pc[sub][0] = packp(s[sub], 0); pc[sub][1] = packp(s[sub], 1); }
        }
        __syncthreads();
        {
            const int q = tid >> 3, part = tid & 7;
            unsigned bits = 0u;
            if (qt >= 16) {
                float v[32];
#pragma unroll
                for (int j = 0; j < 32; ++j) { const LAS float* a = impW + q * 32 + j; v[j] = ((a[0] + a[2048]) + a[4096]) + a[6144]; }
#pragma unroll
                for (int jj = 0; jj < 4; ++jj) { const int j = part * 4 + jj;
                    if (j >= 1 && j <= qt - 2) { const LAS float* a = impW + q * 32 + j; const float vj = ((a[0] + a[2048]) + a[4096]) + a[6144]; int rank = 0;
#pragma unroll
                        for (int i = 1; i < 32; ++i) { const bool cand = (i <= qt - 2); rank += (cand && (v[i] > vj || (v[i] == vj && i < j))) ? 1 : 0; }
                        if (rank < 13) bits |= 1u << j; } }
                bits |= __shfl_xor(bits, 1); bits |= __shfl_xor(bits, 2); bits |= __shfl_xor(bits, 4);
                bits |= 1u | (1u << qt) | (1u << (qt - 1));
            } else bits = (2u << qt) - 1u;
            if (part == 0) selm[q] = bits;
        }
        __syncthreads();
        const unsigned mysel = selm[32 * qh + r32];
        const float g0 = GT[tok * 32 + head * 3 + 0], g1 = GT[tok * 32 + head * 3 + 1], g2 = GT[tok * 32 + head * 3 + 2];
        f32x16 o[2];
        {
#pragma unroll
            for (int r = 0; r < 16; ++r) { o[0][r] = 0.f; o[1][r] = 0.f; }
#pragma unroll
            for (int sub = 0; sub < 4; ++sub) pv_sub(o, pc[sub][0], pc[sub][1], lds + L_VC + (sub >> 1) * 8192, sub & 1, vb);
            if (hi == 0) fac[r32] = g0;
            LDS_WAIT();
#pragma unroll
            for (int r = 0; r < 16; ++r) { const float f = facl[cr(r)]; totL[r * 64] = o[0][r] * f; totL[(16 + r) * 64] = o[1][r] * f; }
            LDS_WAIT();
        }
        bf16x8 qr[4];
#pragma unroll
        for (int ks = 0; ks < 4; ++ks) qr[ks] = *(const bf16x8*)(QRb + tok * 512 + head * 64 + ks * 16 + hi * 8);
        const int nsel = qt + 1, nwin = (qt < 8 ? qt : 8) + 1, ntile = nsel + nwin;
        const bf16* kvb = KV + (size_t)(b * SEQ) * 768 + g * 64;
        u32x4 kreg, vreg;
        {
            kreg = *(const u32x4*)(kvb + (size_t)lane * 768 + 256 + wid * 8); vreg = *(const u32x4*)(kvb + (size_t)vkey * 768 + 384 + vd);
            *(LAS u32x4*)(lds + L_K + tid * 16) = kreg; *(LAS u32x4*)(lds + L_V + tid * 16) = vreg;
        }
        __syncthreads();
        float mrun = -1e30f, lrun = 0.f;
#pragma unroll
        for (int r = 0; r < 16; ++r) { o[0][r] = 0.f; o[1][r] = 0.f; }
        for (int i = 0; i < ntile; ++i) {
            const int buf = i & 1; const bool iswin = i >= nsel; const int kt = iswin ? qt - (nwin - 1) + (i - nsel) : i;
            if (i + 1 < ntile) { const int i1 = i + 1; const bool w1 = i1 >= nsel; const int kt1 = w1 ? qt - (nwin - 1) + (i1 - nsel) : i1; const int co = w1 ? 512 : 256;
                kreg = *(const u32x4*)(kvb + (size_t)(kt1 * 64 + lane) * 768 + co + wid * 8); vreg = *(const u32x4*)(kvb + (size_t)(kt1 * 64 + vkey) * 768 + co + 128 + vd); }
            if (i == nsel) {
                float lt = lrun + __shfl_xor(lrun, 32);
                if (hi == 0) fac[r32] = g1 / fmaxf(lt, 1e-30f);
                LDS_WAIT();
#pragma unroll
                for (int r = 0; r < 16; ++r) { const float f = facl[cr(r)]; totL[r * 64] += o[0][r] * f; totL[(16 + r) * 64] += o[1][r] * f; o[0][r] = 0.f; o[1][r] = 0.f; }
                mrun = -1e30f; lrun = 0.f;
                LDS_WAIT();
            }
            const LAS unsigned char* kb = lds + L_K + buf * 8192 + hi * 1024 + r32 * 16;
            f32x16 p0, p1;
#pragma unroll
            for (int r = 0; r < 16; ++r) { p0[r] = 0.f; p1[r] = 0.f; }
#pragma unroll
            for (int ks = 0; ks < 4; ++ks) { const bf16x8 a0 = *(const LAS bf16x8*)(kb + ks * 2048), a1 = *(const LAS bf16x8*)(kb + ks * 2048 + 512);
                p0 = __builtin_amdgcn_mfma_f32_32x32x16_bf16(a0, qr[ks], p0, 0, 0, 0); p1 = __builtin_amdgcn_mfma_f32_32x32x16_bf16(a1, qr[ks], p1, 0, 0, 0); }
            const bool blk_ok = iswin ? true : ((mysel >> kt) & 1u) != 0u;
            float mx = -INFINITY;
            const bool edge = (kt == qt) || (iswin && kt == qt - 8);
            if (edge) { const int d0 = qpos - kt * 64 - 4 * hi;
#pragma unroll
                for (int r = 0; r < 16; ++r) {
                    const bool ok0 = blk_ok && (cr(r) <= d0) && (!iswin || cr(r) + 512 > d0), ok1 = blk_ok && (cr(r) + 32 <= d0) && (!iswin || cr(r) + 544 > d0);
                    p0[r] = ok0 ? p0[r] * SC : -INFINITY; p1[r] = ok1 ? p1[r] * SC : -INFINITY; mx = fmaxf(mx, fmaxf(p0[r], p1[r])); }
            } else {
#pragma unroll
                for (int r = 0; r < 16; ++r) { p0[r] = blk_ok ? p0[r] * SC : -INFINITY; p1[r] = blk_ok ? p1[r] * SC : -INFINITY; mx = fmaxf(mx, fmaxf(p0[r], p1[r])); }
            }
            mx = fmaxf(mx, __shfl_xor(mx, 32));
            const float mnew = fmaxf(mrun, mx), alpha = __builtin_amdgcn_exp2f(mrun - mnew); mrun = mnew;
            float ls = 0.f;
#pragma unroll
            for (int r = 0; r < 16; ++r) { p0[r] = __builtin_amdgcn_exp2f(p0[r] - mnew); p1[r] = __builtin_amdgcn_exp2f(p1[r] - mnew); ls += p0[r] + p1[r]; }
            lrun = lrun * alpha + ls;
            if (__any(alpha != 1.f)) {
                if (hi == 0) fac[r32] = alpha;
                LDS_WAIT();
#pragma unroll
                for (int r = 0; r < 16; ++r) { const float f = facl[cr(r)]; o[0][r] *= f; o[1][r] *= f; }
                LDS_WAIT();
            }
            const LAS unsigned char* vt = lds + L_V + buf * 8192;
            pv_sub(o, packp(p0, 0), packp(p0, 1), vt, 0, vb); pv_sub(o, packp(p1, 0), packp(p1, 1), vt, 1, vb);
            if (i + 1 < ntile) { *(LAS u32x4*)(lds + L_K + (buf ^ 1) * 8192 + tid * 16) = kreg; *(LAS u32x4*)(lds + L_V + (buf ^ 1) * 8192 + tid * 16) = vreg; }
            __syncthreads();
        }
        {
            float lt = lrun + __shfl_xor(lrun, 32);
            if (hi == 0) fac[r32] = g2 / fmaxf(lt, 1e-30f);
            LDS_WAIT();
            bf16* orow = Ob + ((size_t)b * SEQ + q0 + 32 * qh + 4 * hi) * 512 + head * 64 + r32;
#pragma unroll
            for (int r = 0; r < 16; ++r) { const float f = facl[cr(r)]; const float t0 = totL[r * 64] + o[0][r] * f, t1 = totL[(16 + r) * 64] + o[1][r] * f;
                orow[cr(r) * 512] = (bf16)f2bf(t0); orow[cr(r) * 512 + 32] = (bf16)f2bf(t1); }
        }
        __syncthreads();
    }
}
}

__device__ __forceinline__ void ln_phase(float* X, const float* gam, const float* bet, bf16* XB) {
    const int lane = threadIdx.x & 63, wave = threadIdx.x >> 6; const int gw = blockIdx.x * 8 + wave, NGW = gridDim.x * 8;
    f32x4 gv[4], bv[4];
#pragma unroll
    for (int j = 0; j < 4; ++j) { gv[j] = ((const f32x4*)gam)[lane + 64 * j]; bv[j] = ((const f32x4*)bet)[lane + 64 * j]; }
    for (int m = gw; m < M; m += NGW) {
        f32x4* xr = (f32x4*)(X + (size_t)m * DM) + lane; f32x4 v[4]; float s = 0.f;
#pragma unroll
        for (int j = 0; j < 4; ++j) { v[j] = xr[64 * j]; s += (v[j][0] + v[j][1]) + (v[j][2] + v[j][3]); }
        const float mean = wave_sum(s) * (1.f / DM); float s2 = 0.f;
#pragma unroll
        for (int j = 0; j < 4; ++j) { v[j] = v[j] - mean; s2 += (v[j][0] * v[j][0] + v[j][1] * v[j][1]) + (v[j][2] * v[j][2] + v[j][3] * v[j][3]); }
        const float rstd = 1.f / sqrtf(wave_sum(s2) * (1.f / DM) + LN_EPS);
#pragma unroll
        for (int j = 0; j < 4; ++j) { const f32x4 y = v[j] * rstd * gv[j] + bv[j]; xr[64 * j] = y;
            if (XB) { u32x2 w; w.x = pk2(y[0], y[1]); w.y = pk2(y[2], y[3]); ((u32x2*)(XB + (size_t)m * DM))[lane + 64 * j] = w; } }
    }
}

__global__ void __launch_bounds__(512, 2) mega(Params p) {
    extern __shared__ __attribute__((aligned(16))) unsigned char lds_raw[];
    LAS unsigned char* lds = (LAS unsigned char*)lds_raw;
    cg::grid_group grid = cg::this_grid();
    unsigned char* ws = p.ws;
    const int G = gridDim.x, c = blockIdx.x;
#ifndef PH_MASK
#define PH_MASK 0xffff
#endif
    if (PH_MASK & 1) p0_prologue(p, lds);
    grid.sync();
    if (PH_MASK & 2) {
        pg8::Gemm g{(const bf16*)(ws + WS_XB), (const bf16*)(ws + WS_WIN), M, NINP, DM}; pg8::StaticOrder S; S.init(M, NINP, G, c);
        pg8::EpiProj E{(bf16*)(ws + WS_HBC), (bf16*)(ws + WS_Q), (bf16*)(ws + WS_QR), (bf16*)(ws + WS_KV), (bf16*)(ws + WS_GC), (bf16*)(ws + WS_GN), (float*)(ws + WS_GT), (const float*)(ws + WS_ROPE)};
        pg8::gemm_phase<pg8::EpiProj, pg8::StaticOrder, true, true>(lds, g, S, E);
    }
    grid.sync();
    if (PH_MASK & 4) p2_compress(p, lds);
    if (PH_MASK & 8) p2_conv(p);
    grid.sync();
    if (PH_MASK & 16) att::attn_phase(p, lds);
    grid.sync();
    if (PH_MASK & 32) {
        pg8::Gemm g{(const bf16*)(ws + WS_MIX1), (const bf16*)(ws + WS_WCONV), M, DM, 512}; pg8::StaticOrder S; S.init(M, DM, G, c);
        pg8::EpiGate1 E{(const bf16*)(ws + WS_GC), (float*)(ws + WS_T1)};
        pg8::gemm_phase<pg8::EpiGate1, pg8::StaticOrder, true, true>(lds, g, S, E);
    }
    if (PH_MASK & 64) {
        pg8::Gemm g{(const bf16*)(ws + WS_O), (const bf16*)(ws + WS_WNSA), M, DM, 512}; pg8::StaticOrder S; S.init(M, DM, G, c);
        pg8::EpiGate2 E{(const bf16*)(ws + WS_GN), (const float*)(ws + WS_T1), (bf16*)(ws + WS_XB)};
        pg8::gemm_phase<pg8::EpiGate2, pg8::StaticOrder, true, true>(lds, g, S, E);
    }
    grid.sync();
    if (PH_MASK & 128) {
        pg8::Gemm g{(const bf16*)(ws + WS_XB), (const bf16*)(ws + WS_WO), M, DM, DM}; pg8::StaticOrder S; S.init(M, DM, G, c);
        pg8::EpiRes E{p.x, p.out};
        pg8::gemm_phase<pg8::EpiRes, pg8::StaticOrder, true, true>(lds, g, S, E);
    }
    grid.sync();
    if (PH_MASK & 256) ln_phase(p.out, p.ln1_g, p.ln1_b, (bf16*)(ws + WS_XB));
    grid.sync();
    if (PH_MASK & 512) {
        pg8::Gemm g{(const bf16*)(ws + WS_XB), (const bf16*)(ws + WS_WUP), M, FF, DM}; pg8::StaticOrder S; S.init(M, FF, G, c);
        pg8::EpiUp E{(bf16*)(ws + WS_HB)};
        pg8::gemm_phase<pg8::EpiUp, pg8::StaticOrder, true, true>(lds, g, S, E);
    }
    grid.sync();
    if (PH_MASK & 1024) {
        pg8::Gemm g{(const bf16*)(ws + WS_HB), (const bf16*)(ws + WS_WDOWN), M, DM, FF}; pg8::StaticOrder S; S.init(M, DM, G, c);
        pg8::EpiRes E{p.out, p.out};
        pg8::gemm_phase<pg8::EpiRes, pg8::StaticOrder, true, true>(lds, g, S, E);
    }
    grid.sync();
    if (PH_MASK & 2048) ln_phase(p.out, p.ln2_g, p.ln2_b, nullptr);
}

extern "C" void kernel_launch(void* const* d_in, const int* in_sizes, int n_in, void* d_out, int out_size,
                              void* d_ws, size_t ws_size, hipStream_t stream) {
    static int grid = 0;
    if (!grid) {
        int dev = 0, cus = 0, per_cu = 0;
        (void)hipGetDevice(&dev);
        (void)hipDeviceGetAttribute(&cus, hipDeviceAttributeMultiprocessorCount, dev);
        (void)hipFuncSetAttribute((const void*)mega, hipFuncAttributeMaxDynamicSharedMemorySize, LDS_BYTES);
        (void)hipOccupancyMaxActiveBlocksPerMultiprocessor(&per_cu, (const void*)mega, 512, LDS_BYTES);
        (void)hipGetLastError();
        grid = cus > 0 ? cus : 256;
        if (ws_size < 252 * MiB) fprintf(stderr, "kernel_launch: workspace too small (%zu)\n", ws_size);
    }
    Params p{};
    const float** f = (const float**)&p;
    for (int i = 0; i < 18; ++i) f[i] = (const float*)d_in[i];
    p.out = (float*)d_out; p.ws = (unsigned char*)d_ws;
    void* args[] = {&p};
    hipError_t e = hipLaunchCooperativeKernel((void*)mega, dim3(grid), dim3(512), args, LDS_BYTES, stream);
    if (e != hipSuccess) fprintf(stderr, "cooperative launch failed: %s (grid %d)\n", hipGetErrorString(e), grid);
}
```

```cpp
#include <hip/hip_runtime.h>
#include <hip/hip_cooperative_groups.h>
#include <cstdio>
#include <cstdint>
namespace cg = cooperative_groups;
namespace pg8 {
#define PG8_LAS __attribute__((address_space(3)))
typedef unsigned short bf16_t;
typedef short bf16x8 __attribute__((ext_vector_type(8)));
typedef float f32x4 __attribute__((ext_vector_type(4)));
typedef unsigned u32x4 __attribute__((ext_vector_type(4)));
constexpr int BM = 256, BK = 64, HALF = 128, HTB = HALF * BK * 2  , STAGE_BYTES = 8 * HTB, NXCD = 8, WGM = 8;

__host__ __device__ __forceinline__ int lds_byte(int r, int c) { const int st = (r >> 4) * 2 + (c >> 5), rr = r & 15, cc = c & 31, ob = rr * 64 + cc * 2; return st * 1024 + (ob ^ (((ob >> 9) & 1) << 5)); }
__host__ __device__ __forceinline__ void stage_rc(int b, int& R, int& C) { const int st = b / 1024, sb = b % 1024, swz = sb ^ (((sb >> 9) & 1) << 5); R = (st >> 1) * 16 + swz / 64; C = (st & 1) * 32 + (swz % 64) / 2; }
__host__ __device__ __forceinline__ int perm32(int rho) { const int n = rho >> 4, i = rho & 15; return 8 * (i >> 2) + 4 * n + (i & 3); }

struct Unit { int pm, pn; };
struct Gemm { const bf16_t* A; const bf16_t* Bt; int M, N, K; };

struct StaticOrder {
    int nM, nN, nwg, G, c;
    __host__ __device__ void init(int M, int N, int G_, int c_) { nM = M / BM; nN = N / BM; nwg = nM * nN; G = G_; c = c_; }
    __host__ __device__ bool next(int i, Unit& u) const {
        const long L = (long)i * G + c; if (L >= nwg) return false;
        int wgid = (int)L; { const int q = nwg / NXCD, r = nwg % NXCD, xcd = wgid % NXCD, off = wgid / NXCD; wgid = (xcd < r ? xcd * (q + 1) : r * (q + 1) + (xcd - r) * q) + off; }
        const int nig = WGM * nN, gid = wgid / nig, fm = gid * WGM, gsz = (nM - fm) < WGM ? (nM - fm) : WGM;
        u.pm = fm + ((wgid % nig) % gsz); u.pn = (wgid % nig) / gsz; return true;
    }
    __device__ __forceinline__ void a_ready(const Unit&) const {}
    __device__ __forceinline__ void done(const Unit&) const {}
};

__device__ __forceinline__ unsigned cvt_pk_bf16(float lo, float hi) { unsigned r; asm volatile("v_cvt_pk_bf16_f32 %0, %1, %2" : "=v"(r) : "v"(lo), "v"(hi)); return r; }
typedef float f32x2 __attribute__((ext_vector_type(2)));
template <class Epi, class Sched, bool ALIGN_EPI = false, bool SP2 = false>
__device__ __forceinline__ void gemm_phase(PG8_LAS unsigned char* lds, const Gemm g, const Sched& S, const Epi& E) {
    const int tid = threadIdx.x, wid = __builtin_amdgcn_readfirstlane(tid >> 6), lane = tid & 63, wr = wid >> 2, wc = wid & 3, fr = lane & 15, fq = lane >> 4;
    const int K = g.K, nt = K / BK;
    unsigned voffA[2], voffB[2];
#pragma unroll
    for (int i = 0; i < 2; ++i) { int R, C; stage_rc(tid * 16 + i * 8192, R, C); const int Rb = Epi::PERM ? ((R & ~31) + perm32(R & 31)) : R;
        voffA[i] = (unsigned)(R * K + C) * 2u; voffB[i] = (unsigned)(Rb * K + C) * 2u; }
    const size_t kstep = (size_t)(BK * 2);
    const size_t hstep = (size_t)HALF * K * 2;
    const size_t tstep = 2 * hstep;
    const unsigned ldsw = (unsigned)wid * 1024u;
    const int aoff = lds_byte(wr * 64 + fr, fq * 8), boff = lds_byte(wc * 32 + fr, fq * 8);
#define PG8_SA(b, h) (((b) * 2 + (h)) * HTB)
#define PG8_SB(b, h) ((4 + (b) * 2 + (h)) * HTB)
#define PG8_STAGE(bufoff, gbase, voff) do { _Pragma("unroll") for (int _i = 0; _i < 2; ++_i) \
        __builtin_amdgcn_global_load_lds((const unsigned*)((const char*)(gbase) + (voff)[_i]), (PG8_LAS unsigned*)(lds + (bufoff) + ldsw + _i * 8192), 16, 0, 0); } while (0)
#define PG8_LDA(dst, b, h) do { _Pragma("unroll") for (int m = 0; m < 4; ++m) _Pragma("unroll") for (int k = 0; k < 2; ++k) dst[m][k] = *(const PG8_LAS bf16x8*)(lds + PG8_SA(b, h) + aoff + m * 2048 + k * 1024); } while (0)
#define PG8_LDB(dst, b, h) do { _Pragma("unroll") for (int n = 0; n < 2; ++n) _Pragma("unroll") for (int k = 0; k < 2; ++k) dst[n][k] = *(const PG8_LAS bf16x8*)(lds + PG8_SB(b, h) + boff + n * 2048 + k * 1024); } while (0)
#define PG8_MMA(ai, bj, At, Bt) do { __builtin_amdgcn_s_setprio(1); _Pragma("unroll") for (int m = 0; m < 4; ++m) _Pragma("unroll") for (int n = 0; n < 2; ++n) _Pragma("unroll") for (int k = 0; k < 2; ++k) \
        acc[ai][bj][m][n] = __builtin_amdgcn_mfma_f32_16x16x32_bf16(Bt[n][k], At[m][k], acc[ai][bj][m][n], 0, 0, 0); __builtin_amdgcn_s_setprio(0); } while (0)
#define PG8_WAIT_V(n) asm volatile("s_waitcnt vmcnt(" #n ")" ::: "memory")
#define PG8_WAIT_L(n) asm volatile("s_waitcnt lgkmcnt(" #n ")" ::: "memory")
#define PG8_BAR __builtin_amdgcn_s_barrier()
#define PG8_SCHED __builtin_amdgcn_sched_barrier(0)
    Unit cur, nxt; int ui = 0;
    if (!S.next(0, cur)) return;
    f32x4 acc[2][2][4][2];
#pragma unroll
    for (int a = 0; a < 2; ++a)
#pragma unroll
        for (int b = 0; b < 2; ++b)
#pragma unroll
            for (int m = 0; m < 4; ++m)
#pragma unroll
                for (int n = 0; n < 2; ++n) acc[a][b][m][n] = (f32x4){0.f, 0.f, 0.f, 0.f};
    bf16x8 At[4][2], B0[2][2], B1[2][2];
    const char* cA = (const char*)g.A + (size_t)cur.pm * tstep; const char* cB = (const char*)g.Bt + (size_t)cur.pn * tstep;
    S.a_ready(cur);
    if constexpr (SP2) {
        PG8_STAGE(PG8_SB(0, 0), cB, voffB); PG8_STAGE(PG8_SB(0, 1), cB + hstep, voffB); PG8_STAGE(PG8_SA(0, 0), cA, voffA); PG8_STAGE(PG8_SA(0, 1), cA + hstep, voffA);
        if (wr == 1) PG8_BAR;
        PG8_WAIT_V(2); PG8_BAR;
        PG8_STAGE(PG8_SB(1, 0), cB + kstep, voffB); PG8_STAGE(PG8_SA(1, 0), cA + kstep, voffA); PG8_STAGE(PG8_SB(1, 1), cB + hstep + kstep, voffB);
        PG8_WAIT_V(6); PG8_BAR;
    } else {
        PG8_STAGE(PG8_SB(0, 0), cB, voffB); PG8_STAGE(PG8_SA(0, 0), cA, voffA); PG8_STAGE(PG8_SB(0, 1), cB + hstep, voffB); PG8_STAGE(PG8_SA(0, 1), cA + hstep, voffA);
        if (wr == 1) PG8_BAR;
        PG8_WAIT_V(4); PG8_BAR;
        PG8_STAGE(PG8_SB(1, 0), cB + kstep, voffB); PG8_STAGE(PG8_SA(1, 0), cA + kstep, voffA); PG8_STAGE(PG8_SB(1, 1), cB + hstep + kstep, voffB);
        PG8_WAIT_V(6); PG8_BAR;
    }
    for (;;) {
        const bool has_next = S.next(ui + 1, nxt);
        const char* nA = has_next ? (const char*)g.A + (size_t)nxt.pm * tstep : cA; const char* nB = has_next ? (const char*)g.Bt + (size_t)nxt.pn * tstep : cB;
        for (int t = 0; t < nt; t += 2) {
            const bool last = (t == nt - 2);
            const char* a1 = cA + (size_t)(t + 1) * kstep;
            const char* a2 = last ? nA : cA + (size_t)(t + 2) * kstep; const char* b2 = last ? nB : cB + (size_t)(t + 2) * kstep;
            const char* a3 = a2 + kstep; const char* b3 = b2 + kstep;
            if (last && has_next) S.a_ready(nxt);
            if constexpr (SP2) {
            PG8_LDB(B0, 0, 0); PG8_LDB(B1, 0, 1); PG8_SCHED; PG8_LDA(At, 0, 0); PG8_STAGE(PG8_SA(1, 1), a1 + hstep, voffA);
            PG8_WAIT_V(8); PG8_WAIT_L(0); PG8_BAR; PG8_MMA(0, 0, At, B0); PG8_MMA(0, 1, At, B1); PG8_BAR; PG8_SCHED;
            PG8_LDA(At, 0, 1); PG8_STAGE(PG8_SB(0, 0), b2, voffB); PG8_STAGE(PG8_SB(0, 1), b2 + hstep, voffB); PG8_STAGE(PG8_SA(0, 0), a2, voffA);
            PG8_WAIT_V(8); PG8_WAIT_L(0); PG8_BAR; PG8_MMA(1, 0, At, B0); PG8_MMA(1, 1, At, B1); PG8_BAR; PG8_SCHED;
            PG8_LDB(B0, 1, 0); PG8_LDB(B1, 1, 1); PG8_SCHED; PG8_LDA(At, 1, 0); PG8_STAGE(PG8_SA(0, 1), a2 + hstep, voffA);
            PG8_WAIT_V(8); PG8_WAIT_L(0); PG8_BAR; PG8_MMA(0, 0, At, B0); PG8_MMA(0, 1, At, B1); PG8_BAR; PG8_SCHED;
            PG8_LDA(At, 1, 1); PG8_STAGE(PG8_SB(1, 0), b3, voffB); PG8_STAGE(PG8_SB(1, 1), b3 + hstep, voffB); PG8_STAGE(PG8_SA(1, 0), a3, voffA);
            PG8_WAIT_V(8); PG8_WAIT_L(0); PG8_BAR; PG8_MMA(1, 0, At, B0); PG8_MMA(1, 1, At, B1); PG8_BAR; PG8_SCHED;
            } else {
            PG8_LDB(B0, 0, 0); PG8_SCHED; PG8_LDA(At, 0, 0); PG8_STAGE(PG8_SA(1, 1), a1 + hstep, voffA);
            PG8_WAIT_L(8); PG8_BAR; PG8_WAIT_L(0); PG8_MMA(0, 0, At, B0); PG8_BAR; PG8_SCHED;
            PG8_LDB(B1, 0, 1); PG8_STAGE(PG8_SB(0, 0), b2, voffB);
            PG8_BAR; PG8_WAIT_L(0); PG8_MMA(0, 1, At, B1); PG8_BAR;
            PG8_LDA(At, 0, 1); PG8_STAGE(PG8_SA(0, 0), a2, voffA);
            PG8_BAR; PG8_WAIT_L(0); PG8_MMA(1, 0, At, B0); PG8_BAR; PG8_SCHED;
            PG8_STAGE(PG8_SB(0, 1), b2 + hstep, voffB);
            PG8_WAIT_V(6); PG8_BAR; PG8_MMA(1, 1, At, B1); PG8_BAR;
            PG8_LDB(B0, 1, 0); PG8_SCHED; PG8_LDA(At, 1, 0); PG8_STAGE(PG8_SA(0, 1), a2 + hstep, voffA);
            PG8_WAIT_L(8); PG8_BAR; PG8_WAIT_L(0); PG8_MMA(0, 0, At, B0); PG8_BAR; PG8_SCHED;
            PG8_LDB(B1, 1, 1); PG8_STAGE(PG8_SB(1, 0), b3, voffB);
            PG8_BAR; PG8_WAIT_L(0); PG8_MMA(0, 1, At, B1); PG8_BAR;
            PG8_LDA(At, 1, 1); PG8_STAGE(PG8_SA(1, 0), a3, voffA);
            PG8_BAR; PG8_WAIT_L(0); PG8_MMA(1, 0, At, B0); PG8_BAR; PG8_SCHED;
            PG8_STAGE(PG8_SB(1, 1), b3 + hstep, voffB);
            PG8_WAIT_V(6); PG8_BAR; PG8_MMA(1, 1, At, B1); PG8_BAR;
            }
        }
        if constexpr (ALIGN_EPI) { if (wr == 0) PG8_BAR; }
        if constexpr (!Epi::AFTER_DRAIN) { E(acc, cur, wr, wc, fr, fq); S.done(cur); }
        if (!has_next) break;
#pragma unroll
        for (int a = 0; a < 2; ++a)
#pragma unroll
            for (int b = 0; b < 2; ++b)
#pragma unroll
                for (int m = 0; m < 4; ++m)
#pragma unroll
                    for (int n = 0; n < 2; ++n) acc[a][b][m][n] = (f32x4){0.f, 0.f, 0.f, 0.f};
        cur = nxt; cA = nA; cB = nB; ++ui;
        if constexpr (ALIGN_EPI) { if (wr == 1) PG8_BAR; }
    }
    PG8_WAIT_V(0);
    if constexpr (!ALIGN_EPI) { if (wr == 0) PG8_BAR; }
    PG8_BAR;
    if constexpr (Epi::AFTER_DRAIN) { E.fused(acc, cur, wr, wc, fr, fq, lds, wid, lane); S.done(cur); }
#undef PG8_SA
#undef PG8_SB
#undef PG8_STAGE
#undef PG8_LDA
#undef PG8_LDB
#undef PG8_MMA
#undef PG8_WAIT_V
#undef PG8_WAIT_L
#undef PG8_BAR
#undef PG8_SCHED
}
}

#define LAS __attribute__((address_space(3)))
typedef unsigned short bf16;
typedef unsigned u32x4 __attribute__((ext_vector_type(4)));
typedef unsigned u32x2 __attribute__((ext_vector_type(2)));
typedef float f32x4 __attribute__((ext_vector_type(4)));
typedef float f32x16 __attribute__((ext_vector_type(16)));
typedef short bf16x8 __attribute__((ext_vector_type(8)));
typedef short s16x4 __attribute__((ext_vector_type(4)));

constexpr int M = 16384, DM = 1024, SEQ = 2048, FF = 4096, NINP = 5120, NIN = 4888;
constexpr float ALPHA = 1.189207115002721f;
constexpr float LN_EPS = 1e-5f;
constexpr int LDS_BYTES = 147456;
constexpr size_t MiB = 1u << 20;
constexpr size_t WS_ROPE = 0, WS_CBIAS = 256 * 1024;
constexpr size_t WS_W1T = 1 * MiB, WS_W2T = 2 * MiB, WS_KC = 2 * MiB + 512 * 1024, WS_VC = WS_KC + 256 * 1024;
constexpr size_t WS_WIN = 4 * MiB, WS_WCONV = 14 * MiB, WS_WNSA = 15 * MiB, WS_WO = 16 * MiB, WS_WUP = 18 * MiB, WS_WDOWN = 26 * MiB;
constexpr size_t WS_XB = 34 * MiB;
constexpr size_t WS_HBC = 66 * MiB;
constexpr size_t WS_O = 66 * MiB;
constexpr size_t WS_T1 = 82 * MiB;
constexpr size_t WS_Q = 114 * MiB, WS_QR = 130 * MiB, WS_KV = 146 * MiB, WS_GT = 170 * MiB, WS_GC = 172 * MiB, WS_GN = 204 * MiB, WS_MIX1 = 236 * MiB;
constexpr size_t WS_CTL = 3 * MiB, CTL_BYTES = 65536;
constexpr int LDS_BARST = 147392;
constexpr size_t WS_HB = 66 * MiB;

struct Params {
    const float *x, *w_in, *conv_w, *w_conv_out, *pe_k, *w_k1, *w_k2, *pe_v, *w_v1, *w_v2, *w_nsa_out, *w_o, *ln1_g, *ln1_b, *w_up, *w_down, *ln2_g, *ln2_b;
    float* out; unsigned char* ws;
};

__device__ __forceinline__ unsigned f2bf(float f) { unsigned u = __builtin_bit_cast(unsigned, f); return (u + 0x7fffu + ((u >> 16) & 1u)) >> 16; }
__device__ __forceinline__ unsigned pk2(float lo, float hi) { return pg8::cvt_pk_bf16(lo, hi); }
__device__ __forceinline__ float bflo(unsigned w) { return __builtin_bit_cast(float, w << 16); }
__device__ __forceinline__ float bfhi(unsigned w) { return __builtin_bit_cast(float, w & 0xffff0000u); }
__device__ __forceinline__ float sigm(float v) { return 1.f / (1.f + __expf(-v)); }
__device__ __forceinline__ float wave_sum(float v) {
#pragma unroll
    for (int o = 1; o < 64; o <<= 1) v += __shfl_xor(v, o);
    return v;
}
#define LDS_WAIT() asm volatile("s_waitcnt lgkmcnt(0)" ::: "memory")

namespace pg8 {
struct EpiProj {
    static constexpr bool PERM = true, AFTER_DRAIN = false;
    bf16_t *HBC, *Q, *QR, *KV, *GC, *GN; float* GT; const float* rope;
    __device__ __forceinline__ void operator()(const f32x4 (&acc)[2][2][4][2], const Unit& u, int wr, int wc, int fr, int fq) const {
        const int pn = u.pn; const int row0 = u.pm * BM + wr * 64 + fr; const int cl = wc * 32 + 8 * fq;
        const bool ropew = ((wc & 1) == 0);
#pragma unroll
        for (int ai = 0; ai < 2; ++ai)
#pragma unroll
            for (int m = 0; m < 4; ++m) {
                const int row = row0 + ai * HALF + m * 16;
#pragma unroll
                for (int bj = 0; bj < 2; ++bj) {
                    f32x4 v0 = acc[ai][bj][m][0], v1 = acc[ai][bj][m][1];
                    const int ct = bj * HALF + cl;
                    if (pn < 6) {
                        u32x4 w; w.x = cvt_pk_bf16(v0[0], v0[1]); w.y = cvt_pk_bf16(v0[2], v0[3]); w.z = cvt_pk_bf16(v1[0], v1[1]); w.w = cvt_pk_bf16(v1[2], v1[3]);
                        *(u32x4*)(HBC + (size_t)row * 1536 + pn * 256 + ct) = w;
                    } else if (pn < 11) {
                        const bool isq = pn < 8;
                        if (isq) { u32x4 w; w.x = cvt_pk_bf16(v0[0], v0[1]); w.y = cvt_pk_bf16(v0[2], v0[3]); w.z = cvt_pk_bf16(v1[0], v1[1]); w.w = cvt_pk_bf16(v1[2], v1[3]);
                            *(u32x4*)(Q + (size_t)row * 512 + (pn - 6) * 256 + ct) = w; }
                        const bool dorope = ropew && (isq || (pn >= 9 && bj == 0));
                        if (dorope) {
                            const float* rp = rope + (size_t)(row & (SEQ - 1)) * 16;
                            const f32x4 c0 = *(const f32x4*)(rp), c1 = *(const f32x4*)(rp + 4), s0 = *(const f32x4*)(rp + 8), s1 = *(const f32x4*)(rp + 12);
                            f32x4 o0, o1;
#pragma unroll
                            for (int e = 0; e < 4; ++e) { o0[e] = __shfl_xor(v0[e], 16); o1[e] = __shfl_xor(v1[e], 16); }
                            if (fq == 0) { v0 = v0 * c0 - o0 * s0; v1 = v1 * c1 - o1 * s1; }
                            else if (fq == 1) { v0 = v0 * c0 + o0 * s0; v1 = v1 * c1 + o1 * s1; }
                        }
                        u32x4 w; w.x = cvt_pk_bf16(v0[0], v0[1]); w.y = cvt_pk_bf16(v0[2], v0[3]); w.z = cvt_pk_bf16(v1[0], v1[1]); w.w = cvt_pk_bf16(v1[2], v1[3]);
                        if (isq) *(u32x4*)(QR + (size_t)row * 512 + (pn - 6) * 256 + ct) = w;
                        else *(u32x4*)(KV + (size_t)row * 768 + (pn - 8) * 256 + ct) = w;
                    } else if (pn < 19) {
#pragma unroll
                        for (int e = 0; e < 4; ++e) { v0[e] = sigm(v0[e]); v1[e] = sigm(v1[e]); }
                        u32x4 w; w.x = cvt_pk_bf16(v0[0], v0[1]); w.y = cvt_pk_bf16(v0[2], v0[3]); w.z = cvt_pk_bf16(v1[0], v1[1]); w.w = cvt_pk_bf16(v1[2], v1[3]);
                        bf16_t* dst = (pn < 15) ? GC + (size_t)row * 1024 + (pn - 11) * 256 + ct : GN + (size_t)row * 1024 + (pn - 15) * 256 + ct;
                        *(u32x4*)dst = w;
                    } else {
                        if (bj == 0 && wc == 0) {
#pragma unroll
                            for (int e = 0; e < 4; ++e) { v0[e] = sigm(v0[e]); v1[e] = sigm(v1[e]); }
                            *(f32x4*)(GT + (size_t)row * 32 + cl) = v0; *(f32x4*)(GT + (size_t)row * 32 + cl + 4) = v1;
                        }
                    }
                }
            }
    }
};
struct EpiGate1 {
    static constexpr bool PERM = true, AFTER_DRAIN = false;
    const bf16_t* G; float* T1;
    __device__ __forceinline__ void operator()(const f32x4 (&acc)[2][2][4][2], const Unit& u, int wr, int wc, int fr, int fq) const {
        const int row0 = u.pm * BM + wr * 64 + fr; const int col0 = u.pn * BM + wc * 32 + 8 * fq;
#pragma unroll
        for (int ai = 0; ai < 2; ++ai)
#pragma unroll
            for (int m = 0; m < 4; ++m) { const size_t off = (size_t)(row0 + ai * HALF + m * 16) * 1024 + col0;
#pragma unroll
                for (int bj = 0; bj < 2; ++bj) { const u32x4 g = *(const u32x4*)(G + off + bj * HALF); const f32x4 v0 = acc[ai][bj][m][0], v1 = acc[ai][bj][m][1];
                    f32x4 o0, o1; o0[0] = v0[0] * bflo(g.x); o0[1] = v0[1] * bfhi(g.x); o0[2] = v0[2] * bflo(g.y); o0[3] = v0[3] * bfhi(g.y);
                    o1[0] = v1[0] * bflo(g.z); o1[1] = v1[1] * bfhi(g.z); o1[2] = v1[2] * bflo(g.w); o1[3] = v1[3] * bfhi(g.w);
                    *(f32x4*)(T1 + off + bj * HALF) = o0; *(f32x4*)(T1 + off + bj * HALF + 4) = o1; } }
    }
};
struct EpiGate2 {
    static constexpr bool PERM = true, AFTER_DRAIN = false;
    const bf16_t* G; const float* T1; bf16_t* O;
    __device__ __forceinline__ void operator()(const f32x4 (&acc)[2][2][4][2], const Unit& u, int wr, int wc, int fr, int fq) const {
        const int row0 = u.pm * BM + wr * 64 + fr; const int col0 = u.pn * BM + wc * 32 + 8 * fq;
#pragma unroll
        for (int ai = 0; ai < 2; ++ai)
#pragma unroll
            for (int m = 0; m < 4; ++m) { const size_t off = (size_t)(row0 + ai * HALF + m * 16) * 1024 + col0;
#pragma unroll
                for (int bj = 0; bj < 2; ++bj) { const u32x4 g = *(const u32x4*)(G + off + bj * HALF); const f32x4 v0 = acc[ai][bj][m][0], v1 = acc[ai][bj][m][1];
                    const f32x4 t0 = *(const f32x4*)(T1 + off + bj * HALF), t1 = *(const f32x4*)(T1 + off + bj * HALF + 4);
                    f32x4 o0, o1; o0[0] = t0[0] + v0[0] * bflo(g.x); o0[1] = t0[1] + v0[1] * bfhi(g.x); o0[2] = t0[2] + v0[2] * bflo(g.y); o0[3] = t0[3] + v0[3] * bfhi(g.y);
                    o1[0] = t1[0] + v1[0] * bflo(g.z); o1[1] = t1[1] + v1[1] * bfhi(g.z); o1[2] = t1[2] + v1[2] * bflo(g.w); o1[3] = t1[3] + v1[3] * bfhi(g.w);
                    u32x4 w; w.x = cvt_pk_bf16(o0[0], o0[1]); w.y = cvt_pk_bf16(o0[2], o0[3]); w.z = cvt_pk_bf16(o1[0], o1[1]); w.w = cvt_pk_bf16(o1[2], o1[3]);
                    *(u32x4*)(O + off + bj * HALF) = w; } }
    }
};
struct EpiRes {
    static constexpr bool PERM = false, AFTER_DRAIN = false;
    const float* base; float* out;
    __device__ __forceinline__ void operator()(const f32x4 (&acc)[2][2][4][2], const Unit& u, int wr, int wc, int fr, int fq) const {
        const int row0 = u.pm * BM + wr * 64 + fr; const int col0 = u.pn * BM + wc * 32 + 4 * fq;
#pragma unroll
        for (int ai = 0; ai < 2; ++ai)
#pragma unroll
            for (int m = 0; m < 4; ++m) { const size_t off = (size_t)(row0 + ai * HALF + m * 16) * 1024 + col0;
#pragma unroll
                for (int bj = 0; bj < 2; ++bj)
#pragma unroll
                    for (int n = 0; n < 2; ++n) { const f32x4 b = *(const f32x4*)(base + off + bj * HALF + n * 16); *(f32x4*)(out + off + bj * HALF + n * 16) = b * ALPHA + acc[ai][bj][m][n]; } }
    }
};
struct EpiUp {
    static constexpr bool PERM = true, AFTER_DRAIN = false;
    bf16_t* O;
    __device__ __forceinline__ void operator()(const f32x4 (&acc)[2][2][4][2], const Unit& u, int wr, int wc, int fr, int fq) const {
        const int row0 = u.pm * BM + wr * 64 + fr; const int col0 = u.pn * BM + wc * 32 + 8 * fq;
#pragma unroll
        for (int ai = 0; ai < 2; ++ai)
#pragma unroll
            for (int m = 0; m < 4; ++m) { const size_t off = (size_t)(row0 + ai * HALF + m * 16) * FF + col0;
#pragma unroll
                for (int bj = 0; bj < 2; ++bj) { f32x4 v0 = acc[ai][bj][m][0], v1 = acc[ai][bj][m][1];
#pragma unroll
                    for (int e = 0; e < 4; ++e) { const float a = fmaxf(v0[e], 0.f), b = fmaxf(v1[e], 0.f); v0[e] = a * a; v1[e] = b * b; }
                    u32x4 w; w.x = cvt_pk_bf16(v0[0], v0[1]); w.y = cvt_pk_bf16(v0[2], v0[3]); w.z = cvt_pk_bf16(v1[0], v1[1]); w.w = cvt_pk_bf16(v1[2], v1[3]);
                    *(u32x4*)(O + off + bj * HALF) = w; } }
    }
};
}

template <int MODE>
__device__ __forceinline__ void p0_transpose_item(const float* W, int K, int N, int Nd, bf16* WT, LAS float* scr, int item, int lane) {
    const int nblk = Nd / 32, kb = item / nblk, nb = item % nblk, k0 = 64 * kb, n0 = 32 * nb;
    int sc = n0 + (lane & 31); bool ok = true;
    if (MODE == 1) { const int nd = sc; if (nd < 2816) sc = nd; else if (nd < 4864) sc = nd + 24; else if (nd < 4888) sc = nd - 4864 + 2816; else ok = false; }
#pragma unroll 8
    for (int i = 0; i < 32; ++i) { const int kk = 2 * i + (lane >> 5); scr[kk * 33 + (lane & 31)] = ok ? W[(size_t)(k0 + kk) * N + sc] : 0.f; }
    LDS_WAIT();
    const int c = lane & 7;
#pragma unroll
    for (int j = 0; j < 4; ++j) { const int n = (lane >> 3) + 8 * j; const LAS float* s = scr + (8 * c) * 33 + n;
        u32x4 o; o.x = pk2(s[0 * 33], s[1 * 33]); o.y = pk2(s[2 * 33], s[3 * 33]); o.z = pk2(s[4 * 33], s[5 * 33]); o.w = pk2(s[6 * 33], s[7 * 33]);
        *(u32x4*)(WT + (size_t)(n0 + n) * K + k0 + 8 * c) = o; }
    LDS_WAIT();
}

__device__ __forceinline__ void p0_prologue(const Params& p, LAS unsigned char* lds) {
    const int tid = threadIdx.x, lane = tid & 63, wave = tid >> 6;
    LAS float* scr = (LAS float*)(lds + wave * 16384);
    const int gw = blockIdx.x * 8 + wave, NGW = gridDim.x * 8;
    unsigned char* ws = p.ws;
    constexpr int I_IN = 16 * 160, I_CV = 8 * 32, I_NS = 8 * 32, I_O = 16 * 32, I_UP = 16 * 128, I_DN = 64 * 32, I_W1 = 32 * 4, I_W2 = 2 * 2;
    constexpr int NITEMS = I_IN + I_CV + I_NS + I_O + I_UP + I_DN + 2 * I_W1 + 2 * I_W2;
    for (int it = gw; it < NITEMS; it += NGW) {
        int r = it;
        if (r < I_IN) { p0_transpose_item<1>(p.w_in, 1024, NIN, NINP, (bf16*)(ws + WS_WIN), scr, r, lane); continue; } r -= I_IN;
        if (r < I_CV) { p0_transpose_item<0>(p.w_conv_out, 512, 1024, 1024, (bf16*)(ws + WS_WCONV), scr, r, lane); continue; } r -= I_CV;
        if (r < I_NS) { p0_transpose_item<0>(p.w_nsa_out, 512, 1024, 1024, (bf16*)(ws + WS_WNSA), scr, r, lane); continue; } r -= I_NS;
        if (r < I_O) { p0_transpose_item<0>(p.w_o, 1024, 1024, 1024, (bf16*)(ws + WS_WO), scr, r, lane); continue; } r -= I_O;
        if (r < I_UP) { p0_transpose_item<0>(p.w_up, 1024, 4096, 4096, (bf16*)(ws + WS_WUP), scr, r, lane); continue; } r -= I_UP;
        if (r < I_DN) { p0_transpose_item<0>(p.w_down, 4096, 1024, 1024, (bf16*)(ws + WS_WDOWN), scr, r, lane); continue; } r -= I_DN;
        if (r < I_W1) { p0_transpose_item<0>(p.w_k1, 2048, 128, 128, (bf16*)(ws + WS_W1T), scr, r, lane); continue; } r -= I_W1;
        if (r < I_W1) { p0_transpose_item<0>(p.w_v1, 2048, 128, 128, (bf16*)(ws + WS_W1T + 512 * 1024), scr, r, lane); continue; } r -= I_W1;
        if (r < I_W2) { p0_transpose_item<0>(p.w_k2, 128, 64, 64, (bf16*)(ws + WS_W2T), scr, r, lane); continue; } r -= I_W2;
        p0_transpose_item<0>(p.w_v2, 128, 64, 64, (bf16*)(ws + WS_W2T + 16384), scr, r, lane);
    }
    for (int m = gw; m < M; m += NGW) {
        const f32x4* xr = (const f32x4*)(p.x + (size_t)m * DM) + lane; u32x2* o8 = (u32x2*)((bf16*)(ws + WS_XB) + (size_t)m * DM) + lane;
#pragma unroll
        for (int j = 0; j < 4; ++j) { const f32x4 v = xr[64 * j]; u32x2 w; w.x = pk2(v[0], v[1]); w.y = pk2(v[2], v[3]); o8[64 * j] = w; }
    }
    for (int o = gw; o < 256; o += NGW) {
        const int kv = o >> 7, h = o & 127; const float* pe = kv ? p.pe_v : p.pe_k; const float* w1 = kv ? p.w_v1 : p.w_k1;
        float s = 0.f;
        for (int i = lane; i < 2048; i += 64) s += pe[i] * w1[(size_t)i * 128 + h];
        s = wave_sum(s);
        if (lane == 0) ((float*)(ws + WS_CBIAS))[o] = s;
    }
    for (int idx = blockIdx.x * 512 + tid; idx < SEQ * 8; idx += gridDim.x * 512) {
        const int t = idx >> 3, i = idx & 7;
        const float inv = (float)exp2(-(double)i * 0.125 * 18.931568569324174);
        const float ang = (float)t * inv;
        const double a = (double)ang, k = rint(a * 0.15915494309189535), r = (a - k * 6.283185307179586) * 0.15915494309189535;
        const float rev = (float)r;
        ((float*)(ws + WS_ROPE))[t * 16 + i] = __builtin_amdgcn_cosf(rev);
        ((float*)(ws + WS_ROPE))[t * 16 + 8 + i] = __builtin_amdgcn_sinf(rev);
    }
}

__device__ __forceinline__ void unpack8(const u32x4 w, float* o) { o[0] = bflo(w.x); o[1] = bfhi(w.x); o[2] = bflo(w.y); o[3] = bfhi(w.y); o[4] = bflo(w.z); o[5] = bfhi(w.z); o[6] = bflo(w.w); o[7] = bfhi(w.w); }
__device__ __forceinline__ void p2_conv(const Params& p) {
    const bf16* HBC = (const bf16*)(p.ws + WS_HBC); bf16* MIX1 = (bf16*)(p.ws + WS_MIX1);
    for (int it = blockIdx.x * 512 + threadIdx.x; it < M * 64; it += gridDim.x * 512) {
        const int row = it >> 6, ch = (it & 63) * 8, t = row & (SEQ - 1);
        const bf16* r0 = HBC + (size_t)row * 1536 + ch;
        float h0[8], c0[8], bg[8], u1[8], u2[8], tmp[8];
        unpack8(*(const u32x4*)(r0), h0); unpack8(*(const u32x4*)(r0 + 512), bg); unpack8(*(const u32x4*)(r0 + 1024), c0);
        if (t >= 1) { unpack8(*(const u32x4*)(r0 - 1536), u1); unpack8(*(const u32x4*)(r0 - 1536 + 1024), tmp);
#pragma unroll
            for (int e = 0; e < 8; ++e) u1[e] *= tmp[e]; }
        else {
#pragma unroll
            for (int e = 0; e < 8; ++e) u1[e] = 0.f; }
        if (t >= 2) { unpack8(*(const u32x4*)(r0 - 3072), u2); unpack8(*(const u32x4*)(r0 - 3072 + 1024), tmp);
#pragma unroll
            for (int e = 0; e < 8; ++e) u2[e] *= tmp[e]; }
        else {
#pragma unroll
            for (int e = 0; e < 8; ++e) u2[e] = 0.f; }
        const f32x4 wa0 = *(const f32x4*)(p.conv_w + ch), wa1 = *(const f32x4*)(p.conv_w + ch + 4), wb0 = *(const f32x4*)(p.conv_w + 512 + ch), wb1 = *(const f32x4*)(p.conv_w + 512 + ch + 4),
                    wc0 = *(const f32x4*)(p.conv_w + 1024 + ch), wc1 = *(const f32x4*)(p.conv_w + 1024 + ch + 4);
        float y[8];
#pragma unroll
        for (int e = 0; e < 8; ++e) { const float w0 = e < 4 ? wa0[e & 3] : wa1[e & 3], w1 = e < 4 ? wb0[e & 3] : wb1[e & 3], w2 = e < 4 ? wc0[e & 3] : wc1[e & 3];
            y[e] = bg[e] * (w0 * u2[e] + w1 * u1[e] + w2 * (c0[e] * h0[e])); }
        u32x4 w; w.x = pk2(y[0], y[1]); w.y = pk2(y[2], y[3]); w.z = pk2(y[4], y[5]); w.w = pk2(y[6], y[7]);
        *(u32x4*)(MIX1 + (size_t)row * 512 + ch) = w;
    }
}
__device__ __forceinline__ float gelu_tanh(float x) { const float u = 0.7978845608028654f * (x + 0.044715f * x * x * x); const float e = __expf(2.f * u); const float th = 1.f - 2.f / (e + 1.f); return 0.5f * x * (1.f + th); }
__device__ __forceinline__ void p2_compress(const Params& p, LAS unsigned char* lds) {
    const int tid = threadIdx.x, lane = tid & 63, wave = tid >> 6, l15 = lane & 15, kg = lane >> 4;
    LAS bf16* hidL = (LAS bf16*)lds;
    const bf16* KV = (const bf16*)(p.ws + WS_KV);
    for (int u = blockIdx.x; u < 256; u += gridDim.x) {
        const int kv = u >> 7, b = (u >> 4) & 7, g = (u >> 3) & 1, nt = u & 7;
        const bf16* w1t = (const bf16*)(p.ws + WS_W1T + (size_t)kv * 512 * 1024); const bf16* w2t = (const bf16*)(p.ws + WS_W2T + (size_t)kv * 16384);
        const float* bias = (const float*)(p.ws + WS_CBIAS) + kv * 128;
        const int n = nt * 16 + l15;
        const bf16* arow = KV + (size_t)(b * SEQ) * 768 + kv * 128 + g * 64;
        const bf16* brow = w1t + (size_t)(wave * 16 + l15) * 2048 + kg * 8;
        f32x4 acc = {0.f, 0.f, 0.f, 0.f};
#pragma unroll 4
        for (int kk = 0; kk < 64; ++kk) {
            const int k = kk * 32 + kg * 8, l = k >> 6, d = k & 63; int srow = 16 * n + l; srow = srow > SEQ - 1 ? SEQ - 1 : srow;
            const bf16x8 a = *(const bf16x8*)(arow + (size_t)srow * 768 + d);
            const bf16x8 bb = *(const bf16x8*)(brow + kk * 32);
            acc = __builtin_amdgcn_mfma_f32_16x16x32_bf16(a, bb, acc, 0, 0, 0);
        }
        const float bh = bias[wave * 16 + l15];
#pragma unroll
        for (int r = 0; r < 4; ++r) hidL[(4 * kg + r) * 136 + wave * 16 + l15] = (bf16)f2bf(gelu_tanh(acc[r] + bh));
        __syncthreads();
        if (wave < 4) {
            f32x4 o = {0.f, 0.f, 0.f, 0.f};
#pragma unroll
            for (int kk = 0; kk < 4; ++kk) {
                const bf16x8 a = *(const LAS bf16x8*)(hidL + l15 * 136 + kk * 32 + kg * 8);
                const bf16x8 bb = *(const bf16x8*)(w2t + (size_t)(wave * 16 + l15) * 128 + kk * 32 + kg * 8);
                o = __builtin_amdgcn_mfma_f32_16x16x32_bf16(a, bb, o, 0, 0, 0);
            }
            bf16* dst = (bf16*)(p.ws + (kv ? WS_VC : WS_KC)) + (size_t)((b * 2 + g) * 128) * 64;
#pragma unroll
            for (int r = 0; r < 4; ++r) { const int nn = nt * 16 + 4 * kg + r; dst[(size_t)nn * 64 + wave * 16 + l15] = (bf16)(nn < 127 ? f2bf(o[r]) : 0u); }
        }
        __syncthreads();
    }
}

namespace att {
constexpr int L_K = 0, L_V = 16384, L_VC = 32768, L_IMP = 49152, L_TOT = 49152, L_SELM = 114688, L_FAC = 115200;
constexpr float SC = 0.125f * 1.4426950408889634f;
__device__ __forceinline__ constexpr int cr(int r) { return (r & 3) + 8 * (r >> 2); }
typedef short v4i16_t __attribute__((ext_vector_type(4)));
__device__ __forceinline__ s16x4 vtr(const LAS unsigned char* p) { return __builtin_bit_cast(s16x4, __builtin_amdgcn_ds_read_tr16_b64_v4i16((LAS v4i16_t*)p)); }
__device__ __forceinline__ bf16x8 vfrag(const LAS unsigned char* p) { const s16x4 lo = vtr(p), hi = vtr(p + 512); return (bf16x8){lo[0], lo[1], lo[2], lo[3], hi[0], hi[1], hi[2], hi[3]}; }
__device__ __forceinline__ bf16x8 packp(const f32x16& x, int s2) {
    u32x4 w; w.x = pk2(x[8 * s2 + 0], x[8 * s2 + 1]); w.y = pk2(x[8 * s2 + 2], x[8 * s2 + 3]); w.z = pk2(x[8 * s2 + 4], x[8 * s2 + 5]); w.w = pk2(x[8 * s2 + 6], x[8 * s2 + 7]);
    return __builtin_bit_cast(bf16x8, w);
}
__device__ __forceinline__ void pv_sub(f32x16 (&o)[2], const bf16x8 pa0, const bf16x8 pa1, const LAS unsigned char* vt, int sub, int vb) {
#pragma unroll
    for (int dh = 0; dh < 2; ++dh) {
        o[dh] = __builtin_amdgcn_mfma_f32_32x32x16_bf16(pa0, vfrag(vt + vb + dh * 4096 + sub * 2048), o[dh], 0, 0, 0);
        o[dh] = __builtin_amdgcn_mfma_f32_32x32x16_bf16(pa1, vfrag(vt + vb + dh * 4096 + sub * 2048 + 1024), o[dh], 0, 0, 0); }
}

__device__ __forceinline__ void attn_phase(const Params& p, LAS unsigned char* lds) {
    const int tid = threadIdx.x, lane = tid & 63, wid = tid >> 6, r32 = lane & 31, hi = lane >> 5;
    const int z = wid >> 1, qh = wid & 1;
    const bf16* Qb = (const bf16*)(p.ws + WS_Q); const bf16* QRb = (const bf16*)(p.ws + WS_QR); const bf16* KV = (const bf16*)(p.ws + WS_KV);
    const float* GT = (const float*)(p.ws + WS_GT); bf16* Ob = (bf16*)(p.ws + WS_O);
    const bf16* KC = (const bf16*)(p.ws + WS_KC); const bf16* VC = (const bf16*)(p.ws + WS_VC);
    LAS float* fac = (LAS float*)(lds + L_FAC) + wid * 32; LAS float* facl = fac + 4 * hi;
    LAS float* impW = (LAS float*)(lds + L_IMP);
    LAS float* totL = (LAS float*)(lds + L_TOT) + wid * 2048 + lane;
    LAS unsigned* selm = (LAS unsigned*)(lds + L_SELM);
    const int vb = (4 * hi + ((lane & 15) >> 2)) * 64 + ((lane >> 4) & 1) * 32 + (lane & 3) * 8;
    const int vkey = ((tid >> 5) & 7) * 8 + ((tid >> 2) & 7), vd = (tid >> 8) * 32 + (tid & 3) * 8;
    for (int uu = blockIdx.x; uu < 512; uu += gridDim.x) {
        const int bg = (uu & 255) >> 4, qt = (uu < 256) ? (uu & 15) : 31 - (uu & 15);
        const int b = bg >> 1, g = bg & 1, q0 = qt * 64;
        const int qpos = q0 + 32 * qh + r32; const size_t tok = (size_t)b * SEQ + qpos; const int head = g * 4 + z;
#pragma unroll
        for (int T = 0; T < 2; ++T) *(LAS u32x4*)(lds + L_VC + T * 8192 + tid * 16) = *(const u32x4*)(VC + (size_t)(bg * 128 + T * 64 + vkey) * 64 + vd);
        bf16x8 pc[4][2];
        {
            bf16x8 qf[4];
#pragma unroll
            for (int ks = 0; ks < 4; ++ks) qf[ks] = *(const bf16x8*)(Qb + tok * 512 + head * 64 + ks * 16 + hi * 8);
            f32x16 s[4];
#pragma unroll
            for (int sub = 0; sub < 4; ++sub) {
#pragma unroll
                for (int r = 0; r < 16; ++r) s[sub][r] = 0.f;
#pragma unroll
                for (int ks = 0; ks < 4; ++ks) { const bf16x8 kf = *(const bf16x8*)(KC + (size_t)(bg * 128 + sub * 32 + r32) * 64 + ks * 16 + hi * 8);
                    s[sub] = __builtin_amdgcn_mfma_f32_32x32x16_bf16(kf, qf[ks], s[sub], 0, 0, 0); }
            }
            float mx = -1e30f; const int cthr = ((qpos - 31) >> 4) - 4 * hi;
#pragma unroll
            for (int sub = 0; sub < 4; ++sub)
#pragma unroll
                for (int r = 0; r < 16; ++r) { const bool ok = (sub * 32 + cr(r) <= cthr); const float v = ok ? s[sub][r] * SC : -INFINITY; s[sub][r] = v; mx = fmaxf(mx, v); }
            mx = fmaxf(mx, __shfl_xor(mx, 32));
            float l = 0.f;
#pragma unroll
            for (int sub = 0; sub < 4; ++sub)
#pragma unroll
                for (int r = 0; r < 16; ++r) { const float e = __builtin_amdgcn_exp2f(s[sub][r] - mx); s[sub][r] = e; l += e; }
            l += __shfl_xor(l, 32);
            const float linv = 1.f / fmaxf(l, 1e-30f);
#pragma unroll
            for (int sub = 0; sub < 4; ++sub)
#pragma unroll
                for (int r = 0; r < 16; ++r) s[sub][r] *= linv;
            LAS float* iw = impW + (z * 64 + 32 * qh + r32) * 32;
            float prev = 0.f;
#pragma unroll
            for (int i = 0; i < 16; ++i) { const int sub = i >> 2, qd = i & 3;
                const float rv = __shfl_xor(s[sub][4 * qd + 3], 32);
                const float gs = (s[sub][4 * qd] + s[sub][4 * qd + 1]) + (s[sub][4 * qd + 2] + s[sub][4 * qd + 3]);
                iw[8 * sub + 2 * qd + hi] = gs + (hi ? rv : prev); prev = rv; }
#pragma unroll
            for (int sub = 0; sub < 4; ++sub) { pc[sub][0] = packp(s[sub], 0); pc[sub][1] = packp(s[sub], 1); }
        }
        __syncthreads();
        {
            const int q = tid >> 3, part = tid & 7;
            unsigned bits = 0u;
            if (qt >= 16) {
                float v[32];
#pragma unroll
                for (int j = 0; j < 32; ++j) { const LAS float* a = impW + q * 32 + j; v[j] = ((a[0] + a[2048]) + a[4096]) + a[6144]; }
#pragma unroll
                for (int jj = 0; jj < 4; ++jj) { const int j = part * 4 + jj;
                    if (j >= 1 && j <= qt - 2) { const LAS float* a = impW + q * 32 + j; const float vj = ((a[0] + a[2048]) + a[4096]) + a[6144]; int rank = 0;
#pragma unroll
                        for (int i = 1; i < 32; ++i) { const bool cand = (i <= qt - 2); rank += (cand && (v[i] > vj || (v[i] == vj && i < j))) ? 1 : 0; }
                        if (rank < 13) bits |= 1u << j; } }
                bits |= __shfl_xor(bits, 1); bits |= __shfl_xor(bits, 2); bits |= __shfl_xor(bits, 4);
                bits |= 1u | (1u << qt) | (1u << (qt - 1));
            } else bits = (2u << qt) - 1u;
            if (part == 0) selm[q] = bits;
        }
        __syncthreads();
        const unsigned mysel = selm[32 * qh + r32];
        const float g0 = GT[tok * 32 + head * 3 + 0], g1 = GT[tok * 32 + head * 3 + 1], g2 = GT[tok * 32 + head * 3 + 2];
        f32x16 o[2];
        {
#pragma unroll
            for (int r = 0; r < 16; ++r) { o[0][r] = 0.f; o[1][r] = 0.f; }
#pragma unroll
            for (int sub = 0; sub < 4; ++sub) pv_sub(o, pc[sub][0], pc[sub][1], lds + L_VC + (sub >> 1) * 8192, sub & 1, vb);
            if (hi == 0) fac[r32] = g0;
            LDS_WAIT();
#pragma unroll
            for (int r = 0; r < 16; ++r) { const float f = facl[cr(r)]; totL[r * 64] = o[0][r] * f; totL[(16 + r) * 64] = o[1][r] * f; }
            LDS_WAIT();
        }
        bf16x8 qr[4];
#pragma unroll
        for (int ks = 0; ks < 4; ++ks) qr[ks] = *(const bf16x8*)(QRb + tok * 512 + head * 64 + ks * 16 + hi * 8);
        const int nsel = qt + 1, nwin = (qt < 8 ? qt : 8) + 1, ntile = nsel + nwin;
        const bf16* kvb = KV + (size_t)(b * SEQ) * 768 + g * 64;
        u32x4 kreg, vreg;
        {
            kreg = *(const u32x4*)(kvb + (size_t)lane * 768 + 256 + wid * 8); vreg = *(const u32x4*)(kvb + (size_t)vkey * 768 + 384 + vd);
            *(LAS u32x4*)(lds + L_K + tid * 16) = kreg; *(LAS u32x4*)(lds + L_V + tid * 16) = vreg;
        }
        __syncthreads();
        float mrun = -1e30f, lrun = 0.f;
#pragma unroll
        for (int r = 0; r < 16; ++r) { o[0][r] = 0.f; o[1][r] = 0.f; }
        for (int i = 0; i < ntile; ++i) {
            const int buf = i & 1; const bool iswin = i >= nsel; const int kt = iswin ? qt - (nwin - 1) + (i - nsel) : i;
            if (i + 1 < ntile) { const int i1 = i + 1; const bool w1 = i1 >= nsel; const int kt1 = w1 ? qt - (nwin - 1) + (i1 - nsel) : i1; const int co = w1 ? 512 : 256;
                kreg = *(const u32x4*)(kvb + (size_t)(kt1 * 64 + lane) * 768 + co + wid * 8); vreg = *(const u32x4*)(kvb + (size_t)(kt1 * 64 + vkey) * 768 + co + 128 + vd); }
            if (i == nsel) {
                float lt = lrun + __shfl_xor(lrun, 32);
                if (hi == 0) fac[r32] = g1 / fmaxf(lt, 1e-30f);
                LDS_WAIT();
#pragma unroll
                for (int r = 0; r < 16; ++r) { const float f = facl[cr(r)]; totL[r * 64] += o[0][r] * f; totL[(16 + r) * 64] += o[1][r] * f; o[0][r] = 0.f; o[1][r] = 0.f; }
                mrun = -1e30f; lrun = 0.f;
                LDS_WAIT();
            }
            const LAS unsigned char* kb = lds + L_K + buf * 8192 + hi * 1024 + r32 * 16;
            f32x16 p0, p1;
#pragma unroll
            for (int r = 0; r < 16; ++r) { p0[r] = 0.f; p1[r] = 0.f; }
#pragma unroll
            for (int ks = 0; ks < 4; ++ks) { const bf16x8 a0 = *(const LAS bf16x8*)(kb + ks * 2048), a1 = *(const LAS bf16x8*)(kb + ks * 2048 + 512);
                p0 = __builtin_amdgcn_mfma_f32_32x32x16_bf16(a0, qr[ks], p0, 0, 0, 0); p1 = __builtin_amdgcn_mfma_f32_32x32x16_bf16(a1, qr[ks], p1, 0, 0, 0); }
            const bool blk_ok = iswin ? true : ((mysel >> kt) & 1u) != 0u;
            float mx = -INFINITY;
            const bool edge = (kt == qt) || (iswin && kt == qt - 8);
            if (edge) { const int d0 = qpos - kt * 64 - 4 * hi;
#pragma unroll
                for (int r = 0; r < 16; ++r) {
                    const bool ok0 = blk_ok && (cr(r) <= d0) && (!iswin || cr(r) + 512 > d0), ok1 = blk_ok && (cr(r) + 32 <= d0) && (!iswin || cr(r) + 544 > d0);
                    p0[r] = ok0 ? p0[r] * SC : -INFINITY; p1[r] = ok1 ? p1[r] * SC : -INFINITY; mx = fmaxf(mx, fmaxf(p0[r], p1[r])); }
            } else {
#pragma unroll
                for (int r = 0; r < 16; ++r) { p0[r] = blk_ok ? p0[r] * SC : -INFINITY; p1[r] = blk_ok ? p1[r] * SC : -INFINITY; mx = fmaxf(mx, fmaxf(p0[r], p1[r])); }
            }
            mx = fmaxf(mx, __shfl_xor(mx, 32));
            const float mnew = fmaxf(mrun, mx), alpha = __builtin_amdgcn_exp2f(mrun - mnew); mrun = mnew;
            float ls = 0.f;
#pragma unroll
            for (int r = 0; r < 16; ++r) { p0[r] = __builtin_amdgcn_exp2f(p0[r] - mnew); p1[r] = __builtin_amdgcn_exp2f(p1[r] - mnew); ls += p0[r] + p1[r]; }
            lrun = lrun * alpha + ls;
            if (__any(alpha != 1.f)) {
                if (hi == 0) fac[r32] = alpha;
                LDS_WAIT();
#pragma unroll
                for (int r = 0; r < 16; ++r) { const float f = facl[cr(r)]; o[0][r] *= f; o[1][r] *= f; }
                LDS_WAIT();
            }
            const LAS unsigned char* vt = lds + L_V + buf * 8192;
            pv_sub(o, packp(p0, 0), packp(p0, 1), vt, 0, vb); pv_sub(o, packp(p1, 0), packp(p1, 1), vt, 1, vb);
            if (i + 1 < ntile) { *(LAS u32x4*)(lds + L_K + (buf ^ 1) * 8192 + tid * 16) = kreg; *(LAS u32x4*)(lds + L_V + (buf ^ 1) * 8192 + tid * 16) = vreg; }
            __syncthreads();
        }
        {
            float lt = lrun + __shfl_xor(lrun, 32);
            if (hi == 0) fac[r32] = g2 / fmaxf(lt, 1e-30f);
            LDS_WAIT();
            bf16* orow = Ob + ((size_t)b * SEQ + q0 + 32 * qh + 4 * hi) * 512 + head * 64 + r32;
#pragma unroll
            for (int r = 0; r < 16; ++r) { const float f = facl[cr(r)]; const float t0 = totL[r * 64] + o[0][r] * f, t1 = totL[(16 + r) * 64] + o[1][r] * f;
                orow[cr(r) * 512] = (bf16)f2bf(t0); orow[cr(r) * 512 + 32] = (bf16)f2bf(t1); }
        }
        __syncthreads();
    }
}
}

__device__ __forceinline__ void ln_phase(float* X, const float* gam, const float* bet, bf16* XB) {
    const int lane = threadIdx.x & 63, wave = threadIdx.x >> 6; const int gw = blockIdx.x * 8 + wave, NGW = gridDim.x * 8;
    f32x4 gv[4], bv[4];
#pragma unroll
    for (int j = 0; j < 4; ++j) { gv[j] = ((const f32x4*)gam)[lane + 64 * j]; bv[j] = ((const f32x4*)bet)[lane + 64 * j]; }
    for (int m = gw; m < M; m += NGW) {
        f32x4* xr = (f32x4*)(X + (size_t)m * DM) + lane; f32x4 v[4]; float s = 0.f;
#pragma unroll
        for (int j = 0; j < 4; ++j) { v[j] = xr[64 * j]; s += (v[j][0] + v[j][1]) + (v[j][2] + v[j][3]); }
        const float mean = wave_sum(s) * (1.f / DM); float s2 = 0.f;
#pragma unroll
        for (int j = 0; j < 4; ++j) { v[j] = v[j] - mean; s2 += (v[j][0] * v[j][0] + v[j][1] * v[j][1]) + (v[j][2] * v[j][2] + v[j][3] * v[j][3]); }
        const float rstd = 1.f / sqrtf(wave_sum(s2) * (1.f / DM) + LN_EPS);
#pragma unroll
        for (int j = 0; j < 4; ++j) { const f32x4 y = v[j] * rstd * gv[j] + bv[j]; xr[64 * j] = y;
            if (XB) { u32x2 w; w.x = pk2(y[0], y[1]); w.y = pk2(y[2], y[3]); ((u32x2*)(XB + (size_t)m * DM))[lane + 64 * j] = w; } }
    }
}

#define XB_TMO      128
#define XB_XCNT(j)  (256  + 64 * (j))
#define XB_XSUB(j)  (1280 + 64 * (j))
#define XB_XGEN(j)  (2304 + 64 * (j))
#define XB_TOP      3328
#define XB_TOPGEN   3392
#define XCD_BAR_WORDS 3456
#define XB_SPIN_CAP (1u << 18)

__device__ __forceinline__ unsigned xb_ld(unsigned* p)              { return __hip_atomic_load(p, __ATOMIC_RELAXED, __HIP_MEMORY_SCOPE_AGENT); }
__device__ __forceinline__ unsigned xb_add(unsigned* p, unsigned v) { return __hip_atomic_fetch_add(p, v, __ATOMIC_RELAXED, __HIP_MEMORY_SCOPE_AGENT); }
__device__ __forceinline__ unsigned xb_xcc_id() { return (unsigned)__builtin_amdgcn_s_getreg((3 << 11) | 20) & 0xFu; }
#define XB_SPIN(cond, bar) do { unsigned _sp = 0; while (cond) { __builtin_amdgcn_s_sleep(1); \
    if ((++_sp & 255u) == 0u) { if (xb_ld(&(bar)[XB_TMO])) break; if (_sp > XB_SPIN_CAP) { atomicAdd(&(bar)[XB_TMO], 1u); break; } } } } while (0)

struct XcdBarrier {
    unsigned* bar; unsigned x;
    volatile LAS unsigned* st;
};

__device__ __forceinline__ XcdBarrier xcd_barrier_post(unsigned* bar, volatile LAS unsigned* st) {
    XcdBarrier b; b.bar = bar; b.x = xb_xcc_id(); b.st = st;
    if (threadIdx.x == 0) (void)xb_add(&bar[XB_XCNT(b.x)], 1u);
    return b;
}
__device__ __forceinline__ void xcd_barrier_complete(unsigned* bar, unsigned x, unsigned& nloc, unsigned& nx) {
    const unsigned G = gridDim.x * gridDim.y * gridDim.z;
    unsigned sum, cnt, mine, sp = 0u;
    for (;;) {
        sum = 0u; cnt = 0u; mine = 0u;
#pragma unroll
        for (unsigned j = 0; j < 16; ++j) { const unsigned c = xb_ld(&bar[XB_XCNT(j)]); sum += c; cnt += (c > 0u) ? 1u : 0u; mine = (j == x) ? c : mine; }
        if (sum == G) break;
        __builtin_amdgcn_s_sleep(1);
        if ((++sp & 255u) == 0u) { if (xb_ld(&bar[XB_TMO])) break; if (sp > XB_SPIN_CAP) { atomicAdd(&bar[XB_TMO], 1u); break; } }
    }
    nloc = mine > 0u ? mine : 1u; nx = cnt > 0u ? cnt : 1u;
}

__device__ __forceinline__ void xcd_barrier(const XcdBarrier& b) {
    asm volatile("s_waitcnt vmcnt(0)" ::: "memory");
    __syncthreads();
    if (threadIdx.x == 0) {
        unsigned* bar = b.bar;
        __builtin_amdgcn_s_waitcnt(0);
        unsigned nloc = b.st[0], nx = b.st[1];
        if (nloc == 0u) { xcd_barrier_complete(bar, b.x, nloc, nx); b.st[0] = nloc; b.st[1] = nx; }
        const unsigned old = xb_add(&bar[XB_XSUB(b.x)], 1u);
        const unsigned gen = old / nloc;
        if (old + 1u == (gen + 1u) * nloc) {
            __builtin_amdgcn_fence(__ATOMIC_RELEASE, "agent");
            asm volatile("s_waitcnt vmcnt(0)" ::: "memory");
            const unsigned og = xb_add(&bar[XB_TOP], 1u);
            const unsigned tg = og / nx;
            if (og + 1u == (tg + 1u) * nx) xb_add(&bar[XB_TOPGEN], 1u);
            else XB_SPIN(xb_ld(&bar[XB_TOPGEN]) == tg, bar);
            __builtin_amdgcn_fence(__ATOMIC_ACQUIRE, "agent");
            xb_add(&bar[XB_XGEN(b.x)], 1u);
            asm volatile("s_waitcnt vmcnt(0)" ::: "memory");
        } else {
            XB_SPIN(xb_ld(&bar[XB_XGEN(b.x)]) == gen, bar);
            __builtin_amdgcn_fence(__ATOMIC_ACQUIRE, "agent");
            asm volatile("s_waitcnt vmcnt(0)" ::: "memory");
        }
    }
    __syncthreads();
}

#ifndef PROBE_DUP
#define PROBE_DUP -1
#endif
#define RUN_P1() do { pg8::Gemm g{(const bf16*)(ws + WS_XB), (const bf16*)(ws + WS_WIN), M, NINP, DM}; pg8::StaticOrder S; S.init(M, NINP, G, c); \
        pg8::EpiProj E{(bf16*)(ws + WS_HBC), (bf16*)(ws + WS_Q), (bf16*)(ws + WS_QR), (bf16*)(ws + WS_KV), (bf16*)(ws + WS_GC), (bf16*)(ws + WS_GN), (float*)(ws + WS_GT), (const float*)(ws + WS_ROPE)}; \
        pg8::gemm_phase<pg8::EpiProj, pg8::StaticOrder, true, true>(lds, g, S, E); } while (0)
#define RUN_P5() do { { pg8::Gemm g{(const bf16*)(ws + WS_MIX1), (const bf16*)(ws + WS_WCONV), M, DM, 512}; pg8::StaticOrder S; S.init(M, DM, G, c); \
        pg8::EpiGate1 E{(const bf16*)(ws + WS_GC), (float*)(ws + WS_T1)}; \
        pg8::gemm_phase<pg8::EpiGate1, pg8::StaticOrder, true, true>(lds, g, S, E); } \
      { pg8::Gemm g{(const bf16*)(ws + WS_O), (const bf16*)(ws + WS_WNSA), M, DM, 512}; pg8::StaticOrder S; S.init(M, DM, G, c); \
        pg8::EpiGate2 E{(const bf16*)(ws + WS_GN), (const float*)(ws + WS_T1), (bf16*)(ws + WS_XB)}; \
        pg8::gemm_phase<pg8::EpiGate2, pg8::StaticOrder, true, true>(lds, g, S, E); } } while (0)
#define RUN_P6() do { pg8::Gemm g{(const bf16*)(ws + WS_XB), (const bf16*)(ws + WS_WO), M, DM, DM}; pg8::StaticOrder S; S.init(M, DM, G, c); \
        pg8::EpiRes E{p.x, p.out}; \
        pg8::gemm_phase<pg8::EpiRes, pg8::StaticOrder, true, true>(lds, g, S, E); } while (0)
#define RUN_P8() do { pg8::Gemm g{(const bf16*)(ws + WS_XB), (const bf16*)(ws + WS_WUP), M, FF, DM}; pg8::StaticOrder S; S.init(M, FF, G, c); \
        pg8::EpiUp E{(bf16*)(ws + WS_HB)}; \
        pg8::gemm_phase<pg8::EpiUp, pg8::StaticOrder, true, true>(lds, g, S, E); } while (0)
#define RUN_P9() do { pg8::Gemm g{(const bf16*)(ws + WS_HB), (const bf16*)(ws + WS_WDOWN), M, DM, FF}; pg8::StaticOrder S; S.init(M, DM, G, c); \
        pg8::EpiRes E{p.out, p.out}; \
        pg8::gemm_phase<pg8::EpiRes, pg8::StaticOrder, true, true>(lds, g, S, E); } while (0)

__global__ void __launch_bounds__(512, 2) mega(Params p) {
    extern __shared__ __attribute__((aligned(16))) unsigned char lds_raw[];
    LAS unsigned char* lds = (LAS unsigned char*)lds_raw;
    cg::grid_group grid = cg::this_grid();
    unsigned char* ws = p.ws;
    const int G = gridDim.x, c = blockIdx.x;
    if (threadIdx.x < 2) ((LAS unsigned*)(lds + LDS_BARST))[threadIdx.x] = 0u;
    __syncthreads();
    const XcdBarrier xbar = xcd_barrier_post((unsigned*)(ws + WS_CTL), (volatile LAS unsigned*)(lds + LDS_BARST));
#define GSYNC() xcd_barrier(xbar)
    p0_prologue(p, lds);
    if (PROBE_DUP == 0) { grid.sync(); p0_prologue(p, lds); }
    grid.sync();
    RUN_P1();
    if (PROBE_DUP == 1) RUN_P1();
    GSYNC();
    p2_compress(p, lds); p2_conv(p);
    if (PROBE_DUP == 2) { GSYNC(); p2_compress(p, lds); p2_conv(p); }
    GSYNC();
    att::attn_phase(p, lds);
    if (PROBE_DUP == 3) { GSYNC(); att::attn_phase(p, lds); }
    GSYNC();
    RUN_P5();
    if (PROBE_DUP == 5) RUN_P5();
    GSYNC();
    RUN_P6();
    if (PROBE_DUP == 6) RUN_P6();
    GSYNC();
    ln_phase(p.out, p.ln1_g, p.ln1_b, (bf16*)(ws + WS_XB));
    GSYNC();
    RUN_P8();
    if (PROBE_DUP == 8) RUN_P8();
    GSYNC();
    RUN_P9();
    GSYNC();
#ifdef PROBE_SYNCS
    for (int i_ = 0; i_ < PROBE_SYNCS; ++i_) GSYNC();
#endif
    ln_phase(p.out, p.ln2_g, p.ln2_b, nullptr);
}

extern "C" void kernel_launch(void* const* d_in, const int* in_sizes, int n_in, void* d_out, int out_size,
                              void* d_ws, size_t ws_size, hipStream_t stream) {
    static int grid = 0;
    if (!grid) {
        int dev = 0, cus = 0, per_cu = 0;
        (void)hipGetDevice(&dev);
        (void)hipDeviceGetAttribute(&cus, hipDeviceAttributeMultiprocessorCount, dev);
        (void)hipFuncSetAttribute((const void*)mega, hipFuncAttributeMaxDynamicSharedMemorySize, LDS_BYTES);
        (void)hipOccupancyMaxActiveBlocksPerMultiprocessor(&per_cu, (const void*)mega, 512, LDS_BYTES);
        (void)hipGetLastError();
        grid = cus > 0 ? cus : 256;
        if (ws_size < 252 * MiB) fprintf(stderr, "kernel_launch: workspace too small (%zu)\n", ws_size);
    }
    (void)hipMemsetAsync((unsigned char*)d_ws + WS_CTL, 0, CTL_BYTES, stream);
    Params p{};
    const float** f = (const float**)&p;
    for (int i = 0; i < 18; ++i) f[i] = (const float*)d_in[i];
    p.out = (float*)d_out; p.ws = (unsigned char*)d_ws;
    void* args[] = {&p};
    hipError_t e = hipLaunchCooperativeKernel((void*)mega, dim3(grid), dim3(512), args, LDS_BYTES, stream);
    if (e != hipSuccess) fprintf(stderr, "cooperative launch failed: %s (grid %d)\n", hipGetErrorString(e), grid);
}
```
